# Optimizing an MI355X kernel written in HIP

```python
import math
import jax
import jax.numpy as jnp
from jax import lax
import numpy as np

D_MODEL = 1024
BATCH = 8
SEQ = 2048
DEPTH = 2

CHUNK = 64
N_EVEN = (DEPTH + 1) // 2
N_ODD = DEPTH // 2
NORM_EPS = 1e-6

S5_WIDTH = D_MODEL // 2
S5_GROUP = 16
S5_GROUPS = S5_WIDTH // S5_GROUP
S5_STATE = 64

SSD_INNER = D_MODEL
SSD_HEADDIM = 64
SSD_HEADS = SSD_INNER // SSD_HEADDIM
SSD_STATE = 64
SSD_GROUPS = 4
SSD_CONV = 4
SSD_CONV_DIM = SSD_INNER + 2 * SSD_GROUPS * SSD_STATE
EVEN_IN = S5_WIDTH + SSD_INNER + SSD_CONV_DIM + SSD_HEADS
EVEN_MIX = S5_WIDTH + SSD_INNER

RET_HEADS = 4
RET_QK = D_MODEL // 8
RET_V = 2 * RET_QK
RET_KEY_W = RET_HEADS * RET_QK
RET_VAL_W = RET_HEADS * RET_V
ROPE_BASE = 10000.0

GLA_HEADS = 4
GLA_QK = D_MODEL // 8
GLA_V = D_MODEL // 4
GLA_KEY_W = GLA_HEADS * GLA_QK
GLA_VAL_W = GLA_HEADS * GLA_V
GLA_RANK = 16
GLA_TAU = 16.0
ODD_IN = 2 * RET_KEY_W + 2 * RET_VAL_W + 2 * GLA_KEY_W + 2 * GLA_VAL_W + GLA_RANK
ODD_MIX = RET_VAL_W + GLA_VAL_W

FFN_HIDDEN = -(-8 * D_MODEL // (3 * 256)) * 256

kernel_name = "hybrid_s5_ssd_retention_gla_trunk"


def rmsnorm(x, g):
    xf = x.astype(jnp.float32)
    y = xf * lax.rsqrt(jnp.mean(xf * xf, axis=-1, keepdims=True) + NORM_EPS)
    return (y * g.astype(jnp.float32)).astype(x.dtype)


def split_cols(t, sizes):
    parts, start = [], 0
    for s in sizes:
        parts.append(t[..., start:start + s])
        start += s
    return parts


def to_chunks(t):
    bsz, seqlen, nh, d = t.shape
    return t.reshape(bsz, seqlen // CHUNK, CHUNK, nh, d).transpose(1, 0, 3, 2, 4)


def from_chunks(t):
    nc, bsz, nh, c, d = t.shape
    return t.transpose(1, 0, 3, 2, 4).reshape(bsz, nc * c, nh, d)


def causal_depthwise_conv(x, w, b):
    width, ch = w.shape
    y = lax.conv_general_dilated(x, w[:, None, :], window_strides=(1,),
                                 padding=[(width - 1, 0)],
                                 dimension_numbers=('NWC', 'WIO', 'NWC'),
                                 feature_group_count=ch)
    return y + b


def rotary(t):
    seqlen, d = t.shape[1], t.shape[-1]
    half = d // 2
    inv_freq = ROPE_BASE ** (-jnp.arange(half, dtype=jnp.float32) / half)
    ang = jnp.arange(seqlen, dtype=jnp.float32)[:, None] * inv_freq[None, :]
    cos, sin = jnp.cos(ang)[None, :, None, :], jnp.sin(ang)[None, :, None, :]
    t1, t2 = t[..., :half], t[..., half:]
    return jnp.concatenate([t1 * cos - t2 * sin, t1 * sin + t2 * cos], axis=-1)


def s5_combine(left, right):
    al_re, al_im, bl_re, bl_im = left
    ar_re, ar_im, br_re, br_im = right
    return (al_re * ar_re - al_im * ar_im,
            al_re * ar_im + al_im * ar_re,
            ar_re * bl_re - ar_im * bl_im + br_re,
            ar_re * bl_im + ar_im * bl_re + br_im)


def s5_mixer(u, lam_re, lam_im, log_step, b_re, b_im, c_re, c_im, d_skip, glu_w, glu_b):
    f32 = jnp.float32
    bsz, seqlen, _ = u.shape
    ug = u.astype(f32).reshape(bsz, seqlen, S5_GROUPS, S5_GROUP)
    lr, li = lam_re.astype(f32), lam_im.astype(f32)
    step = jnp.exp(log_step.astype(f32))[:, None]
    mag = jnp.exp(lr * step)
    a_re, a_im = mag * jnp.cos(li * step), mag * jnp.sin(li * step)
    den = lr * lr + li * li
    k_re = ((a_re - 1.0) * lr + a_im * li) / den
    k_im = (a_im * lr - (a_re - 1.0) * li) / den
    br, bi = b_re.astype(f32), b_im.astype(f32)
    bb_re = k_re[..., None] * br - k_im[..., None] * bi
    bb_im = k_re[..., None] * bi + k_im[..., None] * br
    bu_re = jnp.einsum('gpn,blgn->lbgp', bb_re, ug)
    bu_im = jnp.einsum('gpn,blgn->lbgp', bb_im, ug)
    shape_a = (seqlen, 1, S5_GROUPS, S5_STATE)
    a_re_t = jnp.broadcast_to(a_re, shape_a)
    a_im_t = jnp.broadcast_to(a_im, shape_a)
    _, _, xs_re, xs_im = lax.associative_scan(s5_combine, (a_re_t, a_im_t, bu_re, bu_im), axis=0)
    y = (jnp.einsum('gnp,lbgp->blgn', c_re.astype(f32), xs_re)
         - jnp.einsum('gnp,lbgp->blgn', c_im.astype(f32), xs_im)
         + d_skip.astype(f32) * ug).reshape(bsz, seqlen, S5_WIDTH)
    z = jax.nn.gelu(y)
    out = z * jax.nn.sigmoid(z @ glu_w.astype(f32) + glu_b.astype(f32))
    return out.astype(u.dtype)


def ssd_mixer(z, xbc, dt_raw, conv_w, conv_b, dt_bias, a_log, d_skip, norm_g):
    f32 = jnp.float32
    bsz, seqlen, _ = z.shape
    nc = seqlen // CHUNK
    xbc = jax.nn.silu(causal_depthwise_conv(xbc.astype(f32), conv_w.astype(f32), conv_b.astype(f32)))
    xs, bm, cm = split_cols(xbc, (SSD_INNER, SSD_GROUPS * SSD_STATE, SSD_GROUPS * SSD_STATE))
    hpg = SSD_HEADS // SSD_GROUPS
    x = xs.reshape(bsz, nc, CHUNK, SSD_HEADS, SSD_HEADDIM)
    bm = jnp.repeat(bm.reshape(bsz, nc, CHUNK, SSD_GROUPS, SSD_STATE), hpg, axis=3)
    cm = jnp.repeat(cm.reshape(bsz, nc, CHUNK, SSD_GROUPS, SSD_STATE), hpg, axis=3)
    dt = jax.nn.softplus(dt_raw.astype(f32) + dt_bias.astype(f32))
    da = (dt * -jnp.exp(a_log.astype(f32))).reshape(bsz, nc, CHUNK, SSD_HEADS).transpose(0, 3, 1, 2)
    xdt = x * dt.reshape(bsz, nc, CHUNK, SSD_HEADS)[..., None]
    a_cum = jnp.cumsum(da, axis=-1)
    causal = jnp.tril(jnp.ones((CHUNK, CHUNK), dtype=bool))
    seg = jnp.exp(jnp.where(causal, a_cum[..., :, None] - a_cum[..., None, :], -jnp.inf))
    scores = jnp.einsum('bclhn,bcshn->bhcls', cm, bm) * seg
    y = jnp.einsum('bhcls,bcshp->bclhp', scores, xdt)
    decay_to_end = jnp.exp(a_cum[..., -1:] - a_cum)
    states = jnp.einsum('bclhn,bhcl,bclhp->cbhpn', bm, decay_to_end, xdt)
    chunk_decay = jnp.exp(a_cum[..., -1]).transpose(2, 0, 1)

    def step(carry, inp):
        st, dec = inp
        return carry * dec[..., None, None] + st, carry

    init = jnp.zeros((bsz, SSD_HEADS, SSD_HEADDIM, SSD_STATE), f32)
    _, prev = lax.scan(step, init, (states, chunk_decay))
    y = y + jnp.einsum('bclhn,cbhpn,bhcl->bclhp', cm, prev, jnp.exp(a_cum))
    y = y + d_skip.astype(f32)[:, None] * x
    y = y.reshape(bsz, seqlen, SSD_INNER) * jax.nn.silu(z.astype(f32))
    return rmsnorm(y, norm_g).astype(z.dtype)


def retention_mixer(q, k, v, g, norm_g):
    f32 = jnp.float32
    bsz, seqlen, _ = q.shape
    qh = rotary(q.astype(f32).reshape(bsz, seqlen, RET_HEADS, RET_QK))
    kh = rotary(k.astype(f32).reshape(bsz, seqlen, RET_HEADS, RET_QK)) * RET_QK ** -0.5
    vh = v.astype(f32).reshape(bsz, seqlen, RET_HEADS, RET_V)
    log_gamma = jnp.log(1.0 - 2.0 ** (-5.0 - jnp.arange(RET_HEADS, dtype=f32)))
    pos = jnp.arange(CHUNK, dtype=f32)
    diff = pos[:, None] - pos[None, :]
    dmat = jnp.where(diff >= 0, jnp.exp(log_gamma[:, None, None] * jnp.maximum(diff, 0.0)), 0.0)
    q_decay = jnp.exp(log_gamma[:, None] * (pos + 1.0))[..., None]
    k_decay = jnp.exp(log_gamma[:, None] * (CHUNK - 1.0 - pos))
    chunk_decay = jnp.exp(log_gamma * CHUNK)[:, None, None]

    def step(state, inp):
        qc, kc, vc = inp
        inner = jnp.einsum('bhid,bhjd->bhij', qc, kc) * dmat
        out = (jnp.einsum('bhij,bhjv->bhiv', inner, vc)
               + jnp.einsum('bhid,bhdv->bhiv', qc, state) * q_decay)
        state = state * chunk_decay + jnp.einsum('bhjd,hj,bhjv->bhdv', kc, k_decay, vc)
        return state, out

    init = jnp.zeros((bsz, RET_HEADS, RET_QK, RET_V), f32)
    _, out = lax.scan(step, init, (to_chunks(qh), to_chunks(kh), to_chunks(vh)))
    o = from_chunks(out)
    mu = jnp.mean(o, axis=-1, keepdims=True)
    var = jnp.mean(jnp.square(o - mu), axis=-1, keepdims=True)
    o = ((o - mu) * lax.rsqrt(var + NORM_EPS)).reshape(bsz, seqlen, RET_VAL_W) * norm_g.astype(f32)
    return (o * jax.nn.silu(g.astype(f32))).astype(q.dtype)


def gla_mixer(q, k, v, a_lr, g, gate_w, gate_b, norm_g):
    f32 = jnp.float32
    bsz, seqlen, _ = q.shape
    log_a = jax.nn.log_sigmoid(a_lr.astype(f32) @ gate_w.astype(f32) + gate_b.astype(f32)) / GLA_TAU
    qh = q.astype(f32).reshape(bsz, seqlen, GLA_HEADS, GLA_QK) * GLA_QK ** -0.5
    kh = k.astype(f32).reshape(bsz, seqlen, GLA_HEADS, GLA_QK)
    vh = v.astype(f32).reshape(bsz, seqlen, GLA_HEADS, GLA_V)
    ah = log_a.reshape(bsz, seqlen, GLA_HEADS, GLA_QK)
    causal = jnp.tril(jnp.ones((CHUNK, CHUNK), dtype=bool))

    def step(state, inp):
        qc, kc, vc, ac = inp
        bcum = jnp.cumsum(ac, axis=2)
        blast = bcum[:, :, -1:, :]
        q_in = qc * jnp.exp(bcum)
        att = jnp.where(causal, jnp.einsum('bhid,bhjd->bhij', q_in, kc * jnp.exp(-bcum)), 0.0)
        out = (jnp.einsum('bhij,bhjv->bhiv', att, vc)
               + jnp.einsum('bhid,bhdv->bhiv', q_in, state))
        state = (state * jnp.exp(blast)[:, :, 0, :, None]
                 + jnp.einsum('bhjd,bhjv->bhdv', kc * jnp.exp(blast - bcum), vc))
        return state, out

    init = jnp.zeros((bsz, GLA_HEADS, GLA_QK, GLA_V), f32)
    _, out = lax.scan(step, init, (to_chunks(qh), to_chunks(kh), to_chunks(vh), to_chunks(ah)))
    o = from_chunks(out)
    o = (o * lax.rsqrt(jnp.mean(o * o, axis=-1, keepdims=True) + NORM_EPS)).reshape(bsz, seqlen, GLA_VAL_W)
    o = o * norm_g.astype(f32)
    return (o * jax.nn.silu(g.astype(f32))).astype(q.dtype)


def swiglu(h, w_gate, w_up, w_down):
    return (jax.nn.silu(h @ w_gate) * (h @ w_up)) @ w_down


def setup_inputs(seed: int = 0) -> dict:
    key = jax.random.key(seed)
    ks = iter(jax.random.split(key, 48))
    f32 = jnp.float32

    def normal(shape, scale):
        return jax.random.normal(next(ks), shape, f32) * scale

    def gain(shape):
        return 1.0 + normal(shape, 0.02)

    def loguniform(shape, lo, hi):
        return jax.random.uniform(next(ks), shape, f32, math.log(lo), math.log(hi))

    x = normal((BATCH, SEQ, D_MODEL), 1.0)
    norm_mix_g = gain((DEPTH, D_MODEL))
    norm_ffn_g = gain((DEPTH, D_MODEL))
    final_norm_g = gain((D_MODEL,))

    ev_in_w = normal((N_EVEN, D_MODEL, EVEN_IN), D_MODEL ** -0.5)
    s5_lam_re = -0.5 + normal((N_EVEN, S5_GROUPS, S5_STATE), 0.01)
    s5_lam_im = (math.pi * jnp.arange(S5_STATE, dtype=f32)) + normal((N_EVEN, S5_GROUPS, S5_STATE), 0.01)
    s5_log_step = loguniform((N_EVEN, S5_GROUPS), 1e-3, 1e-1)
    b_scale = (2.0 * S5_GROUP) ** -0.5
    s5_b_re = normal((N_EVEN, S5_GROUPS, S5_STATE, S5_GROUP), b_scale)
    s5_b_im = normal((N_EVEN, S5_GROUPS, S5_STATE, S5_GROUP), b_scale)
    c_scale = (2.0 * S5_STATE) ** -0.5
    s5_c_re = normal((N_EVEN, S5_GROUPS, S5_GROUP, S5_STATE), c_scale)
    s5_c_im = normal((N_EVEN, S5_GROUPS, S5_GROUP, S5_STATE), c_scale)
    s5_d = normal((N_EVEN, S5_GROUPS, S5_GROUP), 1.0)
    s5_glu_w = normal((N_EVEN, S5_WIDTH, S5_WIDTH), S5_WIDTH ** -0.5)
    s5_glu_b = normal((N_EVEN, S5_WIDTH), 0.02)
    ssd_conv_w = normal((N_EVEN, SSD_CONV, SSD_CONV_DIM), SSD_CONV ** -0.5)
    ssd_conv_b = normal((N_EVEN, SSD_CONV_DIM), 0.02)
    dt0 = jnp.exp(loguniform((N_EVEN, SSD_HEADS), 1e-3, 1e-1))
    ssd_dt_bias = dt0 + jnp.log(-jnp.expm1(-dt0))
    ssd_a_log = jnp.log(jax.random.uniform(next(ks), (N_EVEN, SSD_HEADS), f32, 1.0, 16.0))
    ssd_d = gain((N_EVEN, SSD_HEADS))
    ssd_norm_g = gain((N_EVEN, SSD_INNER))
    ev_out_w = normal((N_EVEN, EVEN_MIX, D_MODEL), EVEN_MIX ** -0.5)

    od_in_w = normal((N_ODD, D_MODEL, ODD_IN), D_MODEL ** -0.5)
    ret_norm_g = gain((N_ODD, RET_VAL_W))
    gla_gate_w = normal((N_ODD, GLA_RANK, GLA_KEY_W), GLA_RANK ** -0.5)
    gla_gate_b = normal((N_ODD, GLA_KEY_W), 0.1)
    gla_norm_g = gain((N_ODD, GLA_VAL_W))
    od_out_w = normal((N_ODD, ODD_MIX, D_MODEL), ODD_MIX ** -0.5)

    ffn_gate_w = normal((DEPTH, D_MODEL, FFN_HIDDEN), D_MODEL ** -0.5)
    ffn_up_w = normal((DEPTH, D_MODEL, FFN_HIDDEN), D_MODEL ** -0.5)
    ffn_down_w = normal((DEPTH, FFN_HIDDEN, D_MODEL), FFN_HIDDEN ** -0.5)

    return {
        "x": x, "norm_mix_g": norm_mix_g, "norm_ffn_g": norm_ffn_g, "final_norm_g": final_norm_g,
        "ev_in_w": ev_in_w, "s5_lam_re": s5_lam_re, "s5_lam_im": s5_lam_im, "s5_log_step": s5_log_step,
        "s5_b_re": s5_b_re, "s5_b_im": s5_b_im, "s5_c_re": s5_c_re, "s5_c_im": s5_c_im, "s5_d": s5_d,
        "s5_glu_w": s5_glu_w, "s5_glu_b": s5_glu_b, "ssd_conv_w": ssd_conv_w, "ssd_conv_b": ssd_conv_b,
        "ssd_dt_bias": ssd_dt_bias, "ssd_a_log": ssd_a_log, "ssd_d": ssd_d, "ssd_norm_g": ssd_norm_g,
        "ev_out_w": ev_out_w, "od_in_w": od_in_w, "ret_norm_g": ret_norm_g, "gla_gate_w": gla_gate_w,
        "gla_gate_b": gla_gate_b, "gla_norm_g": gla_norm_g, "od_out_w": od_out_w,
        "ffn_gate_w": ffn_gate_w, "ffn_up_w": ffn_up_w, "ffn_down_w": ffn_down_w,
    }


def reference(x, norm_mix_g, norm_ffn_g, final_norm_g, ev_in_w, s5_lam_re, s5_lam_im, s5_log_step,
              s5_b_re, s5_b_im, s5_c_re, s5_c_im, s5_d, s5_glu_w, s5_glu_b, ssd_conv_w, ssd_conv_b,
              ssd_dt_bias, ssd_a_log, ssd_d, ssd_norm_g, ev_out_w, od_in_w, ret_norm_g, gla_gate_w,
              gla_gate_b, gla_norm_g, od_out_w, ffn_gate_w, ffn_up_w, ffn_down_w):
    h = x
    for layer in range(DEPTH):
        i = layer // 2
        hn = rmsnorm(h, norm_mix_g[layer])
        if layer % 2 == 0:
            proj = hn @ ev_in_w[i]
            u, z, xbc, dt_raw = split_cols(proj, (S5_WIDTH, SSD_INNER, SSD_CONV_DIM, SSD_HEADS))
            y_a = s5_mixer(u, s5_lam_re[i], s5_lam_im[i], s5_log_step[i], s5_b_re[i], s5_b_im[i],
                           s5_c_re[i], s5_c_im[i], s5_d[i], s5_glu_w[i], s5_glu_b[i])
            y_b = ssd_mixer(z, xbc, dt_raw, ssd_conv_w[i], ssd_conv_b[i], ssd_dt_bias[i],
                            ssd_a_log[i], ssd_d[i], ssd_norm_g[i])
            mix = jnp.concatenate([y_a, y_b], axis=-1) @ ev_out_w[i]
        else:
            proj = hn @ od_in_w[i]
            q_r, k_r, v_r, g_r, q_g, k_g, v_g, a_lr, g_g = split_cols(
                proj, (RET_KEY_W, RET_KEY_W, RET_VAL_W, RET_VAL_W,
                       GLA_KEY_W, GLA_KEY_W, GLA_VAL_W, GLA_RANK, GLA_VAL_W))
            y_c = retention_mixer(q_r, k_r, v_r, g_r, ret_norm_g[i])
            y_d = gla_mixer(q_g, k_g, v_g, a_lr, g_g, gla_gate_w[i], gla_gate_b[i], gla_norm_g[i])
            mix = jnp.concatenate([y_c, y_d], axis=-1) @ od_out_w[i]
        h = h + mix
        hn = rmsnorm(h, norm_ffn_g[layer])
        h = h + swiglu(hn, ffn_gate_w[layer], ffn_up_w[layer], ffn_down_w[layer])
    return rmsnorm(h, final_norm_g)
```

```cpp
#include <hip/hip_runtime.h>
#include <cstdio>
#include <cstdint>

#ifndef MK_PER_PHASE
#define MK_PER_PHASE 0
#endif

#define GAS __attribute__((address_space(1)))
#define LAS __attribute__((address_space(3)))
typedef unsigned short bf16_t;
typedef short bf16x8 __attribute__((ext_vector_type(8)));
typedef float f32x4 __attribute__((ext_vector_type(4)));
typedef float f32x2 __attribute__((ext_vector_type(2)));
typedef unsigned u32x4 __attribute__((ext_vector_type(4)));
typedef unsigned u32x2 __attribute__((ext_vector_type(2)));

constexpr int NB = 8, SEQ = 2048, DM = 1024, T = NB * SEQ;
constexpr int EVEN_IN = 3088, ODD_IN = 6160, FFH = 2816;
constexpr float EPS = 1e-6f;
constexpr int NWAVES = 8, NTHREADS = 512;

constexpr size_t MiB = 1u << 20;
constexpr size_t WS_CTL = 0, CTL_ZERO_BYTES = 65536;
constexpr size_t WS_SSQ = 1 * MiB;
constexpr size_t WS_SSQB = 2 * MiB;
constexpr size_t WS_DT = 3 * MiB;
constexpr size_t WS_ROT = 4 * MiB;
constexpr size_t WS_A64 = 5 * MiB;
constexpr size_t WS_HB = 7 * MiB;
constexpr size_t WS_W0IN = 39 * MiB;
constexpr size_t WS_W0DT = 45 * MiB;
constexpr size_t WS_W0GLU = 45 * MiB + 512 * 1024;
constexpr size_t WS_W0OUT = 46 * MiB;
constexpr size_t WS_W0GU = 49 * MiB;
constexpr size_t WS_W0DN = 60 * MiB;
constexpr size_t WS_S5BC = 66 * MiB;
constexpr size_t WS_S5W1 = 90 * MiB;
constexpr size_t WS_UPERM = 98 * MiB;
constexpr size_t WS_ZS = 116 * MiB;
constexpr size_t WS_XBC = 148 * MiB;
constexpr size_t WS_YAB = 196 * MiB;
constexpr size_t WS_ZG = WS_HB;
constexpr size_t WS_HID0 = 148 * MiB;
constexpr size_t WS_W1IN = 66 * MiB;
constexpr size_t WS_W1ALR = 74 * MiB;
constexpr size_t WS_W1GT = 74 * MiB + 512 * 1024;
constexpr size_t WS_W1OUT = 79 * MiB;
constexpr size_t WS_W1GU = 83 * MiB;
constexpr size_t WS_W1DN = 94 * MiB;
constexpr size_t WS_QKV = 100 * MiB;
constexpr size_t WS_HID1 = 100 * MiB;
constexpr size_t WS_ALR1 = 40 * MiB;
constexpr size_t WS_END = 256 * MiB;

constexpr int CW_BAR = 4096;

__device__ __forceinline__ unsigned f2bf(float f) { unsigned u = __float_as_uint(f); return (u + 0x7fffu + ((u >> 16) & 1u)) >> 16; }
__device__ __forceinline__ unsigned pk2(float lo, float hi) { return f2bf(lo) | (f2bf(hi) << 16); }
__device__ __forceinline__ float bf2f(unsigned h) { return __uint_as_float(h << 16); }
__device__ __forceinline__ float bflo(unsigned w) { return __uint_as_float(w << 16); }
__device__ __forceinline__ float bfhi(unsigned w) { return __uint_as_float(w & 0xffff0000u); }
__device__ __forceinline__ unsigned cvt_pk_bf16(float lo, float hi) { unsigned r; asm volatile("v_cvt_pk_bf16_f32 %0, %1, %2" : "=v"(r) : "v"(lo), "v"(hi)); return r; }
__device__ __forceinline__ float wave_sum(float v) {
#pragma unroll
    for (int o = 1; o < 64; o <<= 1) v += __shfl_xor(v, o);
    return v;
}
__device__ __forceinline__ float sigmoidf_(float x) { return 1.0f / (1.0f + __expf(-x)); }
__device__ __forceinline__ float siluf_(float x) { return x / (1.0f + __expf(-x)); }
__device__ __forceinline__ float gelu_tanh(float x) { const float u = 1.5957691216f * (x + 0.044715f * x * x * x); return x / (1.0f + __expf(-u)); }
__device__ __forceinline__ float ld_coh(const float* p) { return __hip_atomic_load(p, __ATOMIC_RELAXED, __HIP_MEMORY_SCOPE_AGENT); }
#define LDS_WAIT() asm volatile("s_waitcnt lgkmcnt(0)" ::: "memory")
#define VM_WAIT() asm volatile("s_waitcnt vmcnt(0)" ::: "memory")

__device__ __forceinline__ float row_rstd(const float* ssq, int row) {
    const f32x4* p = (const f32x4*)(ssq + (size_t)row * 16);
    const f32x4 a = p[0], b = p[1], c = p[2], d = p[3];
    const float s = ((a.x + a.y) + (a.z + a.w)) + ((b.x + b.y) + (b.z + b.w)) + ((c.x + c.y) + (c.z + c.w)) + ((d.x + d.y) + (d.z + d.w));
    return rsqrtf(s * (1.0f / 1024.0f) + EPS);
}

constexpr int BM = 256, BK = 64, HALF = 128, HTB = HALF * BK * 2, STAGE_BYTES = 8 * HTB;
__device__ __forceinline__ int lds_byte(int r, int c) { const int st = (r >> 4) * 2 + (c >> 5), rr = r & 15, cc = c & 31, ob = rr * 64 + cc * 2; return st * 1024 + (ob ^ (((ob >> 9) & 1) << 5)); }
__device__ __forceinline__ void stage_rc(int b, int& R, int& C) { const int st = b / 1024, sb = b % 1024, swz = sb ^ (((sb >> 9) & 1) << 5); R = (st >> 1) * 16 + swz / 64; C = (st & 1) * 32 + (swz % 64) / 2; }
__device__ __forceinline__ int perm32(int rho) { const int n = rho >> 4, i = rho & 15; return 8 * (i >> 2) + 4 * n + (i & 3); }

struct Unit { const char* a; const char* b; long bjump; int pm, pn, nt, aux; };
struct GDesc { int lda, ldb; long hsA, hsB; };

struct OrdStd {
    const char* A; const char* B; int lda, ldb, nM, nN, nwg, G, c, nt;
    __device__ void init(const void* A_, const void* B_, int lda_, int ldb_, int M, int N, int K, int G_, int c_) { A = (const char*)A_; B = (const char*)B_; lda = lda_; ldb = ldb_; nM = M / BM; nN = N / BM; nwg = nM * nN; G = G_; c = c_; nt = K / BK; }
    __device__ bool next(int i, Unit& u) const {
        const long L = (long)i * G + c; if (c < 0 || L >= nwg) return false;
        int wgid = (int)L; { const int q = nwg / 8, r = nwg % 8, xcd = wgid % 8, off = wgid / 8; wgid = (xcd < r ? xcd * (q + 1) : r * (q + 1) + (xcd - r) * q) + off; }
        const int nig = 8 * nN, gid = wgid / nig, fm = gid * 8, gsz = (nM - fm) < 8 ? (nM - fm) : 8;
        u.pm = fm + ((wgid % nig) % gsz); u.pn = (wgid % nig) / gsz; u.nt = nt; u.bjump = 0; u.aux = 0;
        u.a = A + (size_t)u.pm * BM * lda * 2; u.b = B + (size_t)u.pn * BM * ldb * 2; return true;
    }
    __device__ __forceinline__ void a_ready(const Unit&) const {}
    __device__ __forceinline__ void done(const Unit&) const {}
};

template <class Epi, class Sched, bool ALIGN_EPI>
__device__ __forceinline__ void gemm_phase(LAS unsigned char* lds, const GDesc g, const Sched& S, const Epi& E) {
    const int tid = threadIdx.x, wid = __builtin_amdgcn_readfirstlane(tid >> 6), lane = tid & 63, wr = wid >> 2, wc = wid & 3, fr = lane & 15, fq = lane >> 4;
    unsigned voffA[2], voffB[2];
#pragma unroll
    for (int i = 0; i < 2; ++i) { int R, C; stage_rc(tid * 16 + i * 8192, R, C); const int Rb = Epi::PERM ? ((R & ~31) + perm32(R & 31)) : R;
        voffA[i] = (unsigned)(R * g.lda + C) * 2u; voffB[i] = (unsigned)(Rb * g.ldb + C) * 2u; }
    const long kstep = BK * 2;
    const long hsA = g.hsA, hsB = g.hsB;
    const unsigned ldsw = (unsigned)wid * 1024u;
    const int aoff = lds_byte(wr * 64 + fr, fq * 8), boff = lds_byte(wc * 32 + fr, fq * 8);
#define PG8_SA(b, h) (((b) * 2 + (h)) * HTB)
#define PG8_SB(b, h) ((4 + (b) * 2 + (h)) * HTB)
#define PG8_STAGE(bufoff, gbase, voff) do { _Pragma("unroll") for (int _i = 0; _i < 2; ++_i) \
        __builtin_amdgcn_global_load_lds((const unsigned*)((const char*)(gbase) + (voff)[_i]), (LAS unsigned*)(lds + (bufoff) + ldsw + _i * 8192), 16, 0, 0); } while (0)
#define PG8_LDA(dst, b, h) do { _Pragma("unroll") for (int m = 0; m < 4; ++m) _Pragma("unroll") for (int k = 0; k < 2; ++k) dst[m][k] = *(const LAS bf16x8*)(lds + PG8_SA(b, h) + aoff + m * 2048 + k * 1024); } while (0)
#define PG8_LDB(dst, b, h) do { _Pragma("unroll") for (int n = 0; n < 2; ++n) _Pragma("unroll") for (int k = 0; k < 2; ++k) dst[n][k] = *(const LAS bf16x8*)(lds + PG8_SB(b, h) + boff + n * 2048 + k * 1024); } while (0)
#define PG8_MMA(ai, bj, At, Bt) do { __builtin_amdgcn_s_setprio(1); _Pragma("unroll") for (int m = 0; m < 4; ++m) _Pragma("unroll") for (int n = 0; n < 2; ++n) _Pragma("unroll") for (int k = 0; k < 2; ++k) \
        acc[ai][bj][m][n] = __builtin_amdgcn_mfma_f32_16x16x32_bf16(Bt[n][k], At[m][k], acc[ai][bj][m][n], 0, 0, 0); __builtin_amdgcn_s_setprio(0); } while (0)
#define PG8_WAIT_V(n) asm volatile("s_waitcnt vmcnt(" #n ")" ::: "memory")
#define PG8_WAIT_L(n) asm volatile("s_waitcnt lgkmcnt(" #n ")" ::: "memory")
#define PG8_BAR __builtin_amdgcn_s_barrier()
#define PG8_SCHED __builtin_amdgcn_sched_barrier(0)
    Unit cur, nxt; int ui = 0;
    if (!S.next(0, cur)) return;
    f32x4 acc[2][2][4][2];
#pragma unroll
    for (int a = 0; a < 2; ++a)
#pragma unroll
        for (int b = 0; b < 2; ++b)
#pragma unroll
            for (int m = 0; m < 4; ++m)
#pragma unroll
                for (int n = 0; n < 2; ++n) acc[a][b][m][n] = (f32x4){0.f, 0.f, 0.f, 0.f};
    bf16x8 At[4][2], B0[2][2], B1[2][2];
    const char* cA = cur.a; const char* cB = cur.b;
    S.a_ready(cur);
    PG8_STAGE(PG8_SB(0, 0), cB, voffB); PG8_STAGE(PG8_SB(0, 1), cB + hsB, voffB); PG8_STAGE(PG8_SA(0, 0), cA, voffA); PG8_STAGE(PG8_SA(0, 1), cA + hsA, voffA);
    if (wr == 1) PG8_BAR;
    PG8_WAIT_V(2); PG8_BAR;
    PG8_STAGE(PG8_SB(1, 0), cB + kstep, voffB); PG8_STAGE(PG8_SA(1, 0), cA + kstep, voffA); PG8_STAGE(PG8_SB(1, 1), cB + hsB + kstep, voffB);
    PG8_WAIT_V(6); PG8_BAR;
    for (;;) {
        const bool has_next = S.next(ui + 1, nxt);
        const char* nA = has_next ? nxt.a : cA; const char* nB = has_next ? nxt.b : cB;
        const int nt = cur.nt; const long bjump = cur.bjump;
        for (int t = 0; t < nt; t += 2) {
            const bool last = (t == nt - 2);
            const char* a1 = cA + (size_t)(t + 1) * kstep;
            const char* a2 = last ? nA : cA + (size_t)(t + 2) * kstep; const char* b2 = last ? nB : cB + (size_t)(t + 2) * kstep + bjump;
            const char* a3 = a2 + kstep; const char* b3 = b2 + kstep;
            if (last && has_next) S.a_ready(nxt);
            PG8_LDB(B0, 0, 0); PG8_LDB(B1, 0, 1); PG8_SCHED; PG8_LDA(At, 0, 0); PG8_STAGE(PG8_SA(1, 1), a1 + hsA, voffA);
            PG8_WAIT_V(8); PG8_WAIT_L(0); PG8_BAR; PG8_MMA(0, 0, At, B0); PG8_MMA(0, 1, At, B1); PG8_BAR; PG8_SCHED;
            PG8_LDA(At, 0, 1); PG8_STAGE(PG8_SB(0, 0), b2, voffB); PG8_STAGE(PG8_SB(0, 1), b2 + hsB, voffB); PG8_STAGE(PG8_SA(0, 0), a2, voffA);
            PG8_WAIT_V(8); PG8_WAIT_L(0); PG8_BAR; PG8_MMA(1, 0, At, B0); PG8_MMA(1, 1, At, B1); PG8_BAR; PG8_SCHED;
            PG8_LDB(B0, 1, 0); PG8_LDB(B1, 1, 1); PG8_SCHED; PG8_LDA(At, 1, 0); PG8_STAGE(PG8_SA(0, 1), a2 + hsA, voffA);
            PG8_WAIT_V(8); PG8_WAIT_L(0); PG8_BAR; PG8_MMA(0, 0, At, B0); PG8_MMA(0, 1, At, B1); PG8_BAR; PG8_SCHED;
            PG8_LDA(At, 1, 1); PG8_STAGE(PG8_SB(1, 0), b3, voffB); PG8_STAGE(PG8_SB(1, 1), b3 + hsB, voffB); PG8_STAGE(PG8_SA(1, 0), a3, voffA);
            PG8_WAIT_V(8); PG8_WAIT_L(0); PG8_BAR; PG8_MMA(1, 0, At, B0); PG8_MMA(1, 1, At, B1); PG8_BAR; PG8_SCHED;
        }
        if constexpr (ALIGN_EPI) { if (wr == 0) PG8_BAR; }
        if constexpr (!Epi::AFTER_DRAIN) { E(acc, cur, wr, wc, fr, fq); S.done(cur); }
        if (!has_next) break;
#pragma unroll
        for (int a = 0; a < 2; ++a)
#pragma unroll
            for (int b = 0; b < 2; ++b)
#pragma unroll
                for (int m = 0; m < 4; ++m)
#pragma unroll
                    for (int n = 0; n < 2; ++n) acc[a][b][m][n] = (f32x4){0.f, 0.f, 0.f, 0.f};
        cur = nxt; cA = nA; cB = nB; ++ui;
        if constexpr (ALIGN_EPI) { if (wr == 1) PG8_BAR; }
    }
    PG8_WAIT_V(0);
    if constexpr (!ALIGN_EPI) { if (wr == 0) PG8_BAR; }
    PG8_BAR;
    if constexpr (Epi::AFTER_DRAIN) { E.fused(acc, cur, wr, wc, fr, fq, lds, wid, lane); S.done(cur); }
#undef PG8_SA
#undef PG8_SB
#undef PG8_STAGE
#undef PG8_LDA
#undef PG8_LDB
#undef PG8_MMA
#undef PG8_WAIT_V
#undef PG8_WAIT_L
#undef PG8_BAR
#undef PG8_SCHED
}

__device__ __forceinline__ u32x4 pack8(const f32x4 v0, const f32x4 v1) { u32x4 w; w.x = cvt_pk_bf16(v0[0], v0[1]); w.y = cvt_pk_bf16(v0[2], v0[3]); w.z = cvt_pk_bf16(v1[0], v1[1]); w.w = cvt_pk_bf16(v1[2], v1[3]); return w; }

struct EpiIn0 {
    static constexpr bool PERM = true, AFTER_DRAIN = false;
    const float* ssq; bf16_t* uperm; bf16_t* zs; bf16_t* xbc;
    __device__ __forceinline__ void operator()(const f32x4 (&acc)[2][2][4][2], const Unit& u, int wr, int wc, int fr, int fq) const {
#pragma unroll
        for (int ai = 0; ai < 2; ++ai)
#pragma unroll
            for (int m = 0; m < 4; ++m) {
                const int row = u.pm * BM + ai * HALF + wr * 64 + m * 16 + fr; const float rs = row_rstd(ssq, row);
#pragma unroll
                for (int bj = 0; bj < 2; ++bj) {
                    const int c = u.pn * BM + bj * HALF + wc * 32 + 8 * fq;
                    const u32x4 w = pack8(acc[ai][bj][m][0] * rs, acc[ai][bj][m][1] * rs);
                    bf16_t* dst;
                    if (u.pn < 2) { const int g = c >> 4, m0 = c & 15; dst = uperm + ((size_t)(g * 256 + (row >> 6)) * 1152 + 128 + (row & 63) * 16 + m0); }
                    else if (u.pn < 6) dst = zs + (size_t)row * 1024 + (c - 512);
                    else dst = xbc + (size_t)row * 1536 + (c - 1536);
                    *(u32x4*)dst = w;
                }
            }
    }
};
struct EpiS5A {
    static constexpr bool PERM = false, AFTER_DRAIN = true;
    bf16_t* uperm; const float* a64;
    __device__ __forceinline__ void operator()(const f32x4 (&)[2][2][4][2], const Unit&, int, int, int, int) const {}
    __device__ __forceinline__ void fused(f32x4 (&acc)[2][2][4][2], const Unit& u, int wr, int wc, int fr, int fq, LAS unsigned char* lds, int wid, int lane) const {
        LAS float* S = (LAS float*)lds;
#pragma unroll
        for (int ai = 0; ai < 2; ++ai)
#pragma unroll
            for (int m = 0; m < 4; ++m) { const int r = ai * HALF + wr * 64 + m * 16 + fr;
#pragma unroll
                for (int n = 0; n < 2; ++n) *(LAS f32x4*)(S + r * 128 + wc * 32 + n * 16 + 4 * fq) = acc[ai][0][m][n]; }
        LDS_WAIT(); __syncthreads();
        const int g = u.aux, tid = wid * 64 + lane, b = tid >> 6, p = tid & 63;
        const f32x2 a = *(const f32x2*)(a64 + (size_t)(g * 64 + p) * 2);
        float xr = 0.f, xi = 0.f;
        for (int c = 0; c < 32; ++c) {
            const int r = b * 32 + c;
            bf16_t* dst = uperm + (size_t)(g * 256 + r) * 1152;
            dst[p] = (bf16_t)f2bf(xr); dst[64 + p] = (bf16_t)f2bf(xi);
            const float sr = S[r * 128 + p], si = S[r * 128 + 64 + p];
            const float nr = a.x * xr - a.y * xi + sr, ni = a.x * xi + a.y * xr + si;
            xr = nr; xi = ni;
        }
        __syncthreads();
    }
};
struct EpiS5C {
    static constexpr bool PERM = true, AFTER_DRAIN = false;
    bf16_t* zg;
    __device__ __forceinline__ void operator()(const f32x4 (&acc)[2][2][4][2], const Unit& u, int wr, int wc, int fr, int fq) const {
        const int g = u.aux >> 2, i = u.aux & 3;
#pragma unroll
        for (int ai = 0; ai < 2; ++ai)
#pragma unroll
            for (int m = 0; m < 4; ++m) {
                const int r = ai * HALF + wr * 64 + m * 16 + fr;
#pragma unroll
                for (int bj = 0; bj < 2; ++bj) {
                    const int ct = bj * HALF + wc * 32 + 8 * fq, tp = ct >> 4, n0 = ct & 15;
                    f32x4 v0 = acc[ai][bj][m][0], v1 = acc[ai][bj][m][1];
#pragma unroll
                    for (int j = 0; j < 4; ++j) { v0[j] = gelu_tanh(v0[j]); v1[j] = gelu_tanh(v1[j]); }
                    *(u32x4*)(zg + ((size_t)(r * 64 + 16 * i + tp) * 512 + g * 16 + n0)) = pack8(v0, v1);
                }
            }
    }
};
struct EpiGlu {
    static constexpr bool PERM = true, AFTER_DRAIN = false;
    const bf16_t* zg; const float* bias; bf16_t* yab;
    __device__ __forceinline__ void operator()(const f32x4 (&acc)[2][2][4][2], const Unit& u, int wr, int wc, int fr, int fq) const {
#pragma unroll
        for (int bj = 0; bj < 2; ++bj) {
            const int c = u.pn * BM + bj * HALF + wc * 32 + 8 * fq;
            const f32x4 b0 = *(const f32x4*)(bias + c), b1 = *(const f32x4*)(bias + c + 4);
#pragma unroll
            for (int ai = 0; ai < 2; ++ai)
#pragma unroll
                for (int m = 0; m < 4; ++m) {
                    const int row = u.pm * BM + ai * HALF + wr * 64 + m * 16 + fr;
                    const u32x4 zw = *(const u32x4*)(zg + (size_t)row * 512 + c);
                    f32x4 v0 = acc[ai][bj][m][0] + b0, v1 = acc[ai][bj][m][1] + b1;
                    v0[0] = bflo(zw.x) * sigmoidf_(v0[0]); v0[1] = bfhi(zw.x) * sigmoidf_(v0[1]); v0[2] = bflo(zw.y) * sigmoidf_(v0[2]); v0[3] = bfhi(zw.y) * sigmoidf_(v0[3]);
                    v1[0] = bflo(zw.z) * sigmoidf_(v1[0]); v1[1] = bfhi(zw.z) * sigmoidf_(v1[1]); v1[2] = bflo(zw.w) * sigmoidf_(v1[2]); v1[3] = bfhi(zw.w) * sigmoidf_(v1[3]);
                    *(u32x4*)(yab + (size_t)row * 1536 + 1024 + c) = pack8(v0, v1);
                }
        }
    }
};
struct EpiRes {
    static constexpr bool PERM = false, AFTER_DRAIN = false;
    const float* hin; float* hout; bf16_t* hb; float* ssq;
    __device__ __forceinline__ void operator()(const f32x4 (&acc)[2][2][4][2], const Unit& u, int wr, int wc, int fr, int fq) const {
#pragma unroll
        for (int ai = 0; ai < 2; ++ai)
#pragma unroll
            for (int m = 0; m < 4; ++m) {
                const int row = u.pm * BM + ai * HALF + wr * 64 + m * 16 + fr; float ss = 0.f;
#pragma unroll
                for (int bj = 0; bj < 2; ++bj)
#pragma unroll
                    for (int n = 0; n < 2; ++n) {
                        const size_t off = (size_t)row * 1024 + u.pn * BM + bj * HALF + wc * 32 + n * 16 + 4 * fq;
                        const f32x4 h = *(const f32x4*)(hin + off) + acc[ai][bj][m][n];
                        *(f32x4*)(hout + off) = h;
                        u32x2 w; w.x = cvt_pk_bf16(h[0], h[1]); w.y = cvt_pk_bf16(h[2], h[3]); *(u32x2*)(hb + off) = w;
                        ss += (h[0] * h[0] + h[1] * h[1]) + (h[2] * h[2] + h[3] * h[3]);
                    }
                ss += __shfl_xor(ss, 16); ss += __shfl_xor(ss, 32);
                if (fq == 0) ssq[(size_t)row * 16 + u.pn * 4 + wc] = ss;
            }
    }
};
struct EpiGu {
    static constexpr bool PERM = true, AFTER_DRAIN = false;
    const float* ssq; bf16_t* hid;
    __device__ __forceinline__ void operator()(const f32x4 (&acc)[2][2][4][2], const Unit& u, int wr, int wc, int fr, int fq) const {
#pragma unroll
        for (int ai = 0; ai < 2; ++ai)
#pragma unroll
            for (int m = 0; m < 4; ++m) {
                const int row = u.pm * BM + ai * HALF + wr * 64 + m * 16 + fr; const float rs = row_rstd(ssq, row);
#pragma unroll
                for (int bj = 0; bj < 2; ++bj) {
                    const f32x4 gt = acc[ai][bj][m][0] * rs, up = acc[ai][bj][m][1] * rs;
                    u32x2 w; w.x = cvt_pk_bf16(siluf_(gt[0]) * up[0], siluf_(gt[1]) * up[1]); w.y = cvt_pk_bf16(siluf_(gt[2]) * up[2], siluf_(gt[3]) * up[3]);
                    *(u32x2*)(hid + (size_t)row * FFH + u.pn * 128 + bj * 64 + wc * 16 + 4 * fq) = w;
                }
            }
    }
};
struct EpiIn1 {
    static constexpr bool PERM = true, AFTER_DRAIN = false;
    const float* ssq; const float* rot; bf16_t* qkv;
    __device__ __forceinline__ void operator()(const f32x4 (&acc)[2][2][4][2], const Unit& u, int wr, int wc, int fr, int fq) const {
#pragma unroll
        for (int ai = 0; ai < 2; ++ai)
#pragma unroll
            for (int m = 0; m < 4; ++m) {
                const int row = u.pm * BM + ai * HALF + wr * 64 + m * 16 + fr; const float rs = row_rstd(ssq, row);
#pragma unroll
                for (int bj = 0; bj < 2; ++bj) {
                    const int c = u.pn * BM + bj * HALF + wc * 32 + 8 * fq;
                    f32x4 v0 = acc[ai][bj][m][0] * rs, v1 = acc[ai][bj][m][1] * rs;
                    if (u.pn < 4) {
                        const int i0 = (c & 127) >> 1; const float* cs = rot + ((size_t)(row & 2047) * 64 + i0) * 2;
                        const f32x4 c0 = *(const f32x4*)cs, c1 = *(const f32x4*)(cs + 4);
                        f32x4 o0, o1;
                        o0[0] = v0[0] * c0[0] - v0[1] * c0[1]; o0[1] = v0[0] * c0[1] + v0[1] * c0[0];
                        o0[2] = v0[2] * c0[2] - v0[3] * c0[3]; o0[3] = v0[2] * c0[3] + v0[3] * c0[2];
                        o1[0] = v1[0] * c1[0] - v1[1] * c1[1]; o1[1] = v1[0] * c1[1] + v1[1] * c1[0];
                        o1[2] = v1[2] * c1[2] - v1[3] * c1[3]; o1[3] = v1[2] * c1[3] + v1[3] * c1[2];
                        v0 = o0; v1 = o1;
                    }
                    *(u32x4*)(qkv + (size_t)row * 4096 + c) = pack8(v0, v1);
                }
            }
    }
};
struct EpiGate {
    static constexpr bool PERM = true, AFTER_DRAIN = false;
    const float* ssq; bf16_t* qkv;
    __device__ __forceinline__ void operator()(const f32x4 (&acc)[2][2][4][2], const Unit& u, int wr, int wc, int fr, int fq) const {
#pragma unroll
        for (int ai = 0; ai < 2; ++ai)
#pragma unroll
            for (int m = 0; m < 4; ++m) {
                const int row = u.pm * BM + ai * HALF + wr * 64 + m * 16 + fr; const float rs = row_rstd(ssq, row);
#pragma unroll
                for (int bj = 0; bj < 2; ++bj) {
                    const int c = u.pn * BM + bj * HALF + wc * 32 + 8 * fq;
                    bf16_t* p = qkv + (size_t)row * 4096 + 2048 + c;
                    const u32x4 ow = *(const u32x4*)p;
                    f32x4 v0 = acc[ai][bj][m][0] * rs, v1 = acc[ai][bj][m][1] * rs;
                    v0[0] = bflo(ow.x) * siluf_(v0[0]); v0[1] = bfhi(ow.x) * siluf_(v0[1]); v0[2] = bflo(ow.y) * siluf_(v0[2]); v0[3] = bfhi(ow.y) * siluf_(v0[3]);
                    v1[0] = bflo(ow.z) * siluf_(v1[0]); v1[1] = bfhi(ow.z) * siluf_(v1[1]); v1[2] = bflo(ow.w) * siluf_(v1[2]); v1[3] = bfhi(ow.w) * siluf_(v1[3]);
                    *(u32x4*)p = pack8(v0, v1);
                }
            }
    }
};

struct OrdS5A {
    const char* U; const char* W1; int c;
    __device__ bool next(int i, Unit& u) const {
        if (i != 0 || c < 0 || c >= 32) return false;
        u.pm = 0; u.pn = 0; u.nt = 16; u.bjump = 0; u.aux = c;
        u.a = U + ((size_t)c * 256 * 1152 + 128) * 2; u.b = W1 + (size_t)c * 128 * 1024 * 2; return true;
    }
    __device__ __forceinline__ void a_ready(const Unit&) const {}
    __device__ __forceinline__ void done(const Unit&) const {}
};
struct OrdS5C {
    const char* U; const char* BC; int c;
    __device__ bool next(int k, Unit& u) const {
        if (k != 0 || c < 0 || c >= 128) return false;
        const int g = c >> 2, i = 3 - (c & 3);
        u.pm = 0; u.pn = i; u.nt = 2 + 4 * (i + 1); u.bjump = -768L * (i + 1); u.aux = g * 4 + i;
        u.a = U + (size_t)g * 256 * 1152 * 2; u.b = BC + ((size_t)g * 256 * 1536 + 1024 + 128 * i) * 2; return true;
    }
    __device__ __forceinline__ void a_ready(const Unit&) const {}
    __device__ __forceinline__ void done(const Unit&) const {}
};

#define XB_TMO      128
#define XB_XCNT(j)  (256  + 64 * (j))
#define XB_XSUB(j)  (1280 + 64 * (j))
#define XB_XGEN(j)  (2304 + 64 * (j))
#define XB_TOP      3328
#define XB_TOPGEN   3392
#define XCD_BAR_WORDS 3456
#define XB_SPIN_CAP (1u << 18)
__device__ __forceinline__ unsigned xb_ld(unsigned* p)              { return __hip_atomic_load(p, __ATOMIC_RELAXED, __HIP_MEMORY_SCOPE_AGENT); }
__device__ __forceinline__ unsigned xb_add(unsigned* p, unsigned v) { return __hip_atomic_fetch_add(p, v, __ATOMIC_RELAXED, __HIP_MEMORY_SCOPE_AGENT); }
__device__ __forceinline__ unsigned xb_xcc_id() { return (unsigned)__builtin_amdgcn_s_getreg((3 << 11) | 20) & 0xFu; }
#define XB_SPIN(cond, bar) do { unsigned _sp = 0; while (cond) { __builtin_amdgcn_s_sleep(1); \
    if ((++_sp & 255u) == 0u) { if (xb_ld(&(bar)[XB_TMO])) break; if (_sp > XB_SPIN_CAP) { atomicAdd(&(bar)[XB_TMO], 1u); break; } } } } while (0)
struct XcdBarrier { unsigned* bar; unsigned x; volatile LAS unsigned* st; };
__device__ __forceinline__ XcdBarrier xcd_barrier_post(unsigned* bar, volatile LAS unsigned* st) {
    XcdBarrier b; b.bar = bar; b.x = xb_xcc_id(); b.st = st;
    if (threadIdx.x == 0) (void)xb_add(&bar[XB_XCNT(b.x)], 1u);
    return b;
}
__device__ __forceinline__ void xcd_barrier_complete(unsigned* bar, unsigned x, unsigned& nloc, unsigned& nx) {
    const unsigned G = gridDim.x * gridDim.y * gridDim.z;
    unsigned sum, cnt, mine, sp = 0u;
    for (;;) {
        sum = 0u; cnt = 0u; mine = 0u;
#pragma unroll
        for (unsigned j = 0; j < 16; ++j) { const unsigned c = xb_ld(&bar[XB_XCNT(j)]); sum += c; cnt += (c > 0u) ? 1u : 0u; mine = (j == x) ? c : mine; }
        if (sum == G) break;
        __builtin_amdgcn_s_sleep(1);
        if ((++sp & 255u) == 0u) { if (xb_ld(&bar[XB_TMO])) break; if (sp > XB_SPIN_CAP) { atomicAdd(&bar[XB_TMO], 1u); break; } }
    }
    nloc = mine > 0u ? mine : 1u; nx = cnt > 0u ? cnt : 1u;
}
__device__ __forceinline__ void xcd_barrier(const XcdBarrier& b) {
    asm volatile("s_waitcnt vmcnt(0)" ::: "memory");
    __syncthreads();
    if (threadIdx.x == 0) {
        unsigned* bar = b.bar;
        __builtin_amdgcn_s_waitcnt(0);
        unsigned nloc = b.st[0], nx = b.st[1];
        if (nloc == 0u) { xcd_barrier_complete(bar, b.x, nloc, nx); b.st[0] = nloc; b.st[1] = nx; }
        const unsigned old = xb_add(&bar[XB_XSUB(b.x)], 1u);
        const unsigned gen = old / nloc;
        if (old + 1u == (gen + 1u) * nloc) {
            __builtin_amdgcn_fence(__ATOMIC_RELEASE, "agent");
            asm volatile("s_waitcnt vmcnt(0)" ::: "memory");
            const unsigned og = xb_add(&bar[XB_TOP], 1u);
            const unsigned tg = og / nx;
            if (og + 1u == (tg + 1u) * nx) xb_add(&bar[XB_TOPGEN], 1u);
            else XB_SPIN(xb_ld(&bar[XB_TOPGEN]) == tg, bar);
            __builtin_amdgcn_fence(__ATOMIC_ACQUIRE, "agent");
            xb_add(&bar[XB_XGEN(b.x)], 1u);
            asm volatile("s_waitcnt vmcnt(0)" ::: "memory");
        } else {
            XB_SPIN(xb_ld(&bar[XB_XGEN(b.x)]) == gen, bar);
            __builtin_amdgcn_fence(__ATOMIC_ACQUIRE, "agent");
            asm volatile("s_waitcnt vmcnt(0)" ::: "memory");
        }
    }
    __syncthreads();
}

constexpr int RING_BYTES = 131072, LDSCTL_OFF = RING_BYTES, MISC_OFF = LDSCTL_OFF + 320, LDS_BYTES = 147456;
constexpr int NPH = 16;
struct Args { const float* in[31]; float* out; unsigned char* ws; int ph_lo, ph_hi; };

template <class F>
__device__ __forceinline__ void transpose_item(const F& f, bf16_t* WT, int K, int item, int nblk, LAS float* scr, int lane) {
    const int kb = item / nblk, nb = item % nblk, k0 = 64 * kb, n0 = 32 * nb;
#pragma unroll 8
    for (int i = 0; i < 32; ++i) { const int kk = 2 * i + (lane >> 5); scr[kk * 33 + (lane & 31)] = f.val(k0 + kk, n0 + (lane & 31)); }
    LDS_WAIT(); asm volatile("" ::: "memory");
    const int c = lane & 7;
#pragma unroll
    for (int j = 0; j < 4; ++j) { const int n = (lane >> 3) + 8 * j; const LAS float* s = scr + (8 * c) * 33 + n;
        u32x4 o; o.x = pk2(s[0 * 33], s[1 * 33]); o.y = pk2(s[2 * 33], s[3 * 33]); o.z = pk2(s[4 * 33], s[5 * 33]); o.w = pk2(s[6 * 33], s[7 * 33]);
        *(u32x4*)(WT + (size_t)(n0 + n) * K + k0 + 8 * c) = o; }
    LDS_WAIT(); asm volatile("" ::: "memory");
}
template <class F>
__device__ __forceinline__ void transpose_all(const F& f, bf16_t* WT, int K, int Npad, LAS float* scr, int lane, int gw, int ngw) {
    const int nblk = Npad / 32, nitems = (K / 64) * nblk;
    for (int it = gw; it < nitems; it += ngw) transpose_item(f, WT, K, it, nblk, scr, lane);
}
struct FIn0 { const float* w; const float* g; __device__ __forceinline__ float val(int k, int n) const { return w[(size_t)k * EVEN_IN + n] * g[k]; } };
struct FDt0 { const float* w; const float* g; __device__ __forceinline__ float val(int k, int n) const { return n < 16 ? w[(size_t)k * EVEN_IN + 3072 + n] * g[k] : 0.f; } };
struct FPlain { const float* w; int N; __device__ __forceinline__ float val(int k, int n) const { return w[(size_t)k * N + n]; } };
struct FOut0 { const float* w; const float* g; __device__ __forceinline__ float val(int k, int n) const { return k < 1024 ? w[(size_t)(512 + k) * 1024 + n] * g[k] : w[(size_t)(k - 1024) * 1024 + n]; } };
struct FGu { const float* wg; const float* wu; const float* g; __device__ __forceinline__ float val(int k, int n) const {
    const int tile = n >> 8, q = n & 255, j = tile * 128 + (q >> 3) * 4 + (q & 3); const long dlt = (q & 4) ? (long)(wu - wg) : 0L; return wg[dlt + (long)k * FFH + j] * g[k]; } };
struct FIn1 { const float* w; const float* g; __device__ __forceinline__ float val(int k, int n) const {
    int col; float sc = 1.f;
    if (n < 1024) { const int head = (n & 511) >> 7, pc = n & 127, i = pc >> 1, d = (pc & 1) ? i + 64 : i; col = (n < 512 ? 0 : 512) + head * 128 + d; if (n >= 512) sc = 0.08838834764831845f; }
    else if (n < 1536) { col = 3072 + (n - 1024); sc = 0.08838834764831845f; }
    else if (n < 2048) col = 3584 + (n - 1536);
    else if (n < 3072) col = 1024 + (n - 2048);
    else col = 4096 + (n - 3072);
    return w[(size_t)k * ODD_IN + col] * g[k] * sc; } };
struct FAlr { const float* w; const float* g; __device__ __forceinline__ float val(int k, int n) const { return n < 16 ? w[(size_t)k * ODD_IN + 5120 + n] * g[k] : 0.f; } };
struct FGate { const float* w; const float* g; __device__ __forceinline__ float val(int k, int n) const { const int col = n < 1024 ? 2048 + n : 5136 + (n - 1024); return w[(size_t)k * ODD_IN + col] * g[k]; } };
struct FOut1 { const float* w; const float* gr; const float* gg; __device__ __forceinline__ float val(int k, int n) const { return w[(size_t)k * 1024 + n] * (k < 1024 ? gr[k] : gg[k - 1024]); } };

__device__ __forceinline__ void s5_tables(const Args& A, unsigned char* ws, LAS unsigned char* lds, int g, int tid) {
    LAS f32x2* apow = (LAS f32x2*)lds;
    LAS f32x2* Cc = apow + 65 * 64;
    LAS f32x2* Bb = Cc + 1024;
    LAS float* Kt = (LAS float*)(Bb + 1024);
    const float* lam_re = A.in[5] + g * 64; const float* lam_im = A.in[6] + g * 64;
    const float step = expf(A.in[7][g]);
    const float* b_re = A.in[8] + (size_t)g * 1024; const float* b_im = A.in[9] + (size_t)g * 1024;
    const float* c_re = A.in[10] + (size_t)g * 1024; const float* c_im = A.in[11] + (size_t)g * 1024;
    const float* dsk = A.in[12] + g * 16;
    for (int idx = tid; idx < 65 * 64; idx += NTHREADS) { const int lag = idx >> 6, p = idx & 63; const float lr = lam_re[p], li = lam_im[p];
        const float mag = expf((float)lag * (lr * step)), ang = (float)lag * (li * step); float sn, cs; sincosf(ang, &sn, &cs); apow[idx] = (f32x2){mag * cs, mag * sn}; }
    for (int idx = tid; idx < 1024; idx += NTHREADS) { Cc[idx] = (f32x2){c_re[idx], c_im[idx]};
        const int p = idx >> 4; const float lr = lam_re[p], li = lam_im[p]; const float mag = expf(lr * step); float sn, cs; sincosf(li * step, &sn, &cs);
        const float ar = mag * cs, ai = mag * sn, den = lr * lr + li * li, kr = ((ar - 1.f) * lr + ai * li) / den, ki = (ai * lr - (ar - 1.f) * li) / den;
        const float br = b_re[idx], bi = b_im[idx]; Bb[idx] = (f32x2){kr * br - ki * bi, kr * bi + ki * br}; }
    __syncthreads();
    for (int idx = tid; idx < 16384; idx += NTHREADS) { const int lag = idx >> 8, n = (idx >> 4) & 15, m = idx & 15; float s = 0.f;
        for (int p = 0; p < 64; ++p) { const f32x2 c = Cc[n * 64 + p], a = apow[lag * 64 + p], b = Bb[p * 16 + m];
            const float tr = c.x * a.x - c.y * a.y, ti = c.x * a.y + c.y * a.x; s += tr * b.x - ti * b.y; }
        if (lag == 0 && n == m) s += dsk[n];
        Kt[idx] = s; }
    __syncthreads();
    unsigned* bc = (unsigned*)(ws + WS_S5BC) + (size_t)g * 256 * 768;
    for (int idx = tid; idx < 256 * 768; idx += NTHREADS) { const int r = idx / 768, c2 = (idx % 768) * 2, tp = r >> 4, n = r & 15; float v[2];
#pragma unroll
        for (int e = 0; e < 2; ++e) { const int c = c2 + e;
            if (c < 1024) { const int d = 3 - (c >> 8), kk = c & 255, sp = kk >> 4, m = kk & 15, lag = 16 * d + tp - sp; v[e] = lag >= 0 ? Kt[(lag * 16 + n) * 16 + m] : 0.f; }
            else { const int i = (c - 1024) >> 7, pp = (c - 1024) & 127, p = pp & 63, t = 16 * i + tp; const f32x2 cc = Cc[n * 64 + p], a = apow[(t + 1) * 64 + p];
                v[e] = pp < 64 ? (cc.x * a.x - cc.y * a.y) : -(cc.x * a.y + cc.y * a.x); } }
        bc[idx] = pk2(v[0], v[1]); }
    unsigned* w1 = (unsigned*)(ws + WS_S5W1) + (size_t)g * 128 * 512;
    for (int idx = tid; idx < 128 * 512; idx += NTHREADS) { const int pp = idx >> 9, c2 = (idx & 511) * 2, p = pp & 63; float v[2];
#pragma unroll
        for (int e = 0; e < 2; ++e) { const int c = c2 + e, s = c >> 4, m = c & 15; const f32x2 a = apow[(63 - s) * 64 + p], b = Bb[p * 16 + m];
            v[e] = pp < 64 ? (a.x * b.x - a.y * b.y) : (a.x * b.y + a.y * b.x); }
        w1[idx] = pk2(v[0], v[1]); }
    if (tid < 64) *(f32x2*)((float*)(ws + WS_A64) + (size_t)(g * 64 + tid) * 2) = apow[64 * 64 + tid];
    __syncthreads();
}

__device__ __forceinline__ void skinny16(const bf16_t* hb, const bf16_t* wt, const float* ssq, float* out, int gw, int ngw, int lane) {
    for (int task = gw; task < T / 16; task += ngw) {
        const int r0 = task * 16; f32x4 acc = (f32x4){0.f, 0.f, 0.f, 0.f};
        const bf16_t* ap = hb + (size_t)(r0 + (lane & 15)) * 1024 + (lane >> 4) * 8; const bf16_t* bp = wt + (size_t)(lane & 15) * 1024 + (lane >> 4) * 8;
#pragma unroll 4
        for (int kk = 0; kk < 32; ++kk) { const bf16x8 a = *(const bf16x8*)(ap + kk * 32), b = *(const bf16x8*)(bp + kk * 32); acc = __builtin_amdgcn_mfma_f32_16x16x32_bf16(a, b, acc, 0, 0, 0); }
#pragma unroll
        for (int j = 0; j < 4; ++j) { const int row = r0 + (lane >> 4) * 4 + j; out[(size_t)row * 16 + (lane & 15)] = acc[j] * row_rstd(ssq, row); }
    }
}

__global__ void __launch_bounds__(NTHREADS, 2) mega_fwd(Args args) {
    extern __shared__ __attribute__((aligned(16))) unsigned char lds_raw[];
    LAS unsigned char* lds = (LAS unsigned char*)lds_raw;
    volatile LAS unsigned* MISC = (volatile LAS unsigned*)(lds + MISC_OFF);
    const int tid = threadIdx.x, lane = tid & 63, wave = __builtin_amdgcn_readfirstlane(tid >> 6);
    const int G = gridDim.x, bx = blockIdx.x;
    const int vcu = (G % 8 == 0) ? (bx % 8) * (G / 8) + bx / 8 : bx;
    const int gw = vcu * NWAVES + wave, NGW = G * NWAVES;
    const int gtid = gw * 64 + lane, NGT = NGW * 64;
    unsigned char* ws = args.ws;
    for (int u = tid; u < (LDS_BYTES - LDSCTL_OFF) / 4; u += NTHREADS) ((LAS unsigned*)(lds + LDSCTL_OFF))[u] = 0u;
    __syncthreads();
    XcdBarrier bar; bar.bar = (unsigned*)(ws + WS_CTL) + CW_BAR; bar.x = 0; bar.st = nullptr;
    if (!MK_PER_PHASE) bar = xcd_barrier_post((unsigned*)(ws + WS_CTL) + CW_BAR, MISC + 8);
    const int lo = args.ph_lo, hi = args.ph_hi;
#define IN(k) (lo <= (k) && (k) < hi)
#define SEAM(k) do { if (IN(k) && IN((k) + 1)) xcd_barrier(bar); } while (0)

    float* hres = args.out;
    float* ssq = (float*)(ws + WS_SSQ);
    bf16_t* hb = (bf16_t*)(ws + WS_HB);

    if (IN(0)) {
        LAS float* scr = (LAS float*)(lds + wave * 16384);
        if (bx < 32) s5_tables(args, ws, lds, bx, tid);
        { FIn0 f{args.in[4], args.in[1]}; transpose_all(f, (bf16_t*)(ws + WS_W0IN), 1024, 3072, scr, lane, gw, NGW); }
        { FDt0 f{args.in[4], args.in[1]}; transpose_all(f, (bf16_t*)(ws + WS_W0DT), 1024, 32, scr, lane, gw, NGW); }
        { FPlain f{args.in[13], 512}; transpose_all(f, (bf16_t*)(ws + WS_W0GLU), 512, 512, scr, lane, gw, NGW); }
        { FOut0 f{args.in[21], args.in[20]}; transpose_all(f, (bf16_t*)(ws + WS_W0OUT), 1536, 1024, scr, lane, gw, NGW); }
        { FGu f{args.in[28], args.in[29], args.in[2]}; transpose_all(f, (bf16_t*)(ws + WS_W0GU), 1024, 5632, scr, lane, gw, NGW); }
        { FPlain f{args.in[30], 1024}; transpose_all(f, (bf16_t*)(ws + WS_W0DN), FFH, 1024, scr, lane, gw, NGW); }
        float* rot = (float*)(ws + WS_ROT);
        for (int idx = gtid; idx < 2048 * 64; idx += NGT) { const int l = idx >> 6, i = idx & 63; const float invf = powf(10000.0f, -(float)i / 64.0f), ang = (float)l * invf; float sn, cs; sincosf(ang, &sn, &cs);
            *(f32x2*)(rot + (size_t)idx * 2) = (f32x2){cs, sn}; }
        const float* x = args.in[0];
        for (int row = gw; row < T; row += NGW) {
            const f32x4* xr = (const f32x4*)(x + (size_t)row * 1024) + lane; float s = 0.f; f32x4 v[4];
#pragma unroll
            for (int j = 0; j < 4; ++j) { v[j] = xr[64 * j]; s += (v[j][0] * v[j][0] + v[j][1] * v[j][1]) + (v[j][2] * v[j][2] + v[j][3] * v[j][3]); }
            s = wave_sum(s);
            u32x2* o = (u32x2*)(hb + (size_t)row * 1024) + lane;
#pragma unroll
            for (int j = 0; j < 4; ++j) { u32x2 w; w.x = pk2(v[j][0], v[j][1]); w.y = pk2(v[j][2], v[j][3]); o[64 * j] = w; }
            if (lane < 16) ssq[(size_t)row * 16 + lane] = lane == 0 ? s : 0.f;
        }
    }
    SEAM(0);
    if (IN(1)) {
        skinny16(hb, (const bf16_t*)(ws + WS_W0DT), ssq, (float*)(ws + WS_DT), gw, NGW, lane);
        OrdStd S; S.init(hb, ws + WS_W0IN, 1024, 1024, T, 3072, 1024, G, bx);
        const GDesc gd{1024, 1024, 128L * 1024 * 2, 128L * 1024 * 2};
        EpiIn0 E{ssq, (bf16_t*)(ws + WS_UPERM), (bf16_t*)(ws + WS_ZS), (bf16_t*)(ws + WS_XBC)};
        gemm_phase<EpiIn0, OrdStd, true>(lds, gd, S, E);
    }
    SEAM(1);
    if (IN(2)) {
        if (bx < 32) {
            OrdS5A S{(const char*)(ws + WS_UPERM), (const char*)(ws + WS_S5W1), bx};
            const GDesc gd{1152, 1024, 128L * 1152 * 2, 0};
            EpiS5A E{(bf16_t*)(ws + WS_UPERM), (const float*)(ws + WS_A64)};
            gemm_phase<EpiS5A, OrdS5A, false>(lds, gd, S, E);
        } else {
            const bf16_t* xbc = (const bf16_t*)(ws + WS_XBC); bf16_t* yab = (bf16_t*)(ws + WS_YAB);
            const float* cw = args.in[15]; const float* cb = args.in[16];
            const int t0 = (bx - 32) * NTHREADS + tid, nt_ = (G - 32) * NTHREADS;
            for (int idx = t0; idx < T * 192; idx += nt_) {
                const int row = idx / 192, c8 = (idx % 192) * 8, l = row & 2047;
                float a[8];
#pragma unroll
                for (int j = 0; j < 8; ++j) a[j] = cb[c8 + j];
#pragma unroll
                for (int k = 0; k < 4; ++k) { const int ll = l - 3 + k; if (ll >= 0) { const u32x4 w = *(const u32x4*)(xbc + (size_t)(row - 3 + k) * 1536 + c8);
                    const float* wk = cw + k * 1536 + c8;
                    a[0] += wk[0] * bflo(w.x); a[1] += wk[1] * bfhi(w.x); a[2] += wk[2] * bflo(w.y); a[3] += wk[3] * bfhi(w.y);
                    a[4] += wk[4] * bflo(w.z); a[5] += wk[5] * bfhi(w.z); a[6] += wk[6] * bflo(w.w); a[7] += wk[7] * bfhi(w.w); } }
                u32x4 o; o.x = pk2(siluf_(a[0]), siluf_(a[1])); o.y = pk2(siluf_(a[2]), siluf_(a[3])); o.z = pk2(siluf_(a[4]), siluf_(a[5])); o.w = pk2(siluf_(a[6]), siluf_(a[7]));
                *(u32x4*)(yab + (size_t)row * 1536 + c8) = o;
            }
        }
    }
    SEAM(2);
    if (IN(3)) {
        if (bx < 128) {
            OrdS5C S{(const char*)(ws + WS_UPERM), (const char*)(ws + WS_S5BC), bx};
            const GDesc gd{1152, 1536, 128L * 1152 * 2, 128L * 1536 * 2};
            EpiS5C E{(bf16_t*)(ws + WS_ZG)};
            gemm_phase<EpiS5C, OrdS5C, false>(lds, gd, S, E);
        } else if (wave == 0) {
            for (int task = bx - 128; task < 128; task += (G - 128)) {
                const int b = task >> 4, h = task & 15, grp = h >> 2;
                bf16_t* yab = (bf16_t*)(ws + WS_YAB); const bf16_t* zs = (const bf16_t*)(ws + WS_ZS); const float* dtb = (const float*)(ws + WS_DT); float* ssqb = (float*)(ws + WS_SSQB);
                const float dt_bias = args.in[17][h], aneg = -expf(args.in[18][h]), dsk = args.in[19][h];
                float st[64];
#pragma unroll
                for (int n = 0; n < 64; ++n) st[n] = 0.f;
                for (int t = 0; t < SEQ; ++t) {
                    const size_t row = (size_t)b * SEQ + t;
                    const float xv = bf2f(yab[row * 1536 + h * 64 + lane]), Bv = bf2f(yab[row * 1536 + 1024 + grp * 64 + lane]), Cv = bf2f(yab[row * 1536 + 1280 + grp * 64 + lane]);
                    const float zv = bf2f(zs[row * 1024 + h * 64 + lane]);
                    const float dr = ld_coh(dtb + row * 16 + h) + dt_bias;
                    const float dt = dr > 20.f ? dr : log1pf(expf(dr));
                    const float dec = expf(aneg * dt), xd = xv * dt; float y = 0.f;
#pragma unroll
                    for (int n = 0; n < 64; ++n) { const float bn = __int_as_float(__builtin_amdgcn_readlane(__float_as_int(Bv), n)), cn = __int_as_float(__builtin_amdgcn_readlane(__float_as_int(Cv), n));
                        st[n] = st[n] * dec + xd * bn; y += cn * st[n]; }
                    y += dsk * xv; const float yg = y * siluf_(zv);
                    const float s2 = wave_sum(yg * yg);
                    yab[row * 1536 + h * 64 + lane] = (bf16_t)f2bf(yg);
                    if (lane == 0) ssqb[row * 16 + h] = s2;
                }
            }
        }
    }
    SEAM(3);
    if (IN(4)) {
        if (bx < 128) {
            OrdStd S; S.init(ws + WS_ZG, ws + WS_W0GLU, 512, 512, T, 512, 512, 128, bx);
            const GDesc gd{512, 512, 128L * 512 * 2, 128L * 512 * 2};
            EpiGlu E{(const bf16_t*)(ws + WS_ZG), args.in[14], (bf16_t*)(ws + WS_YAB)};
            gemm_phase<EpiGlu, OrdStd, false>(lds, gd, S, E);
        } else {
            bf16_t* yab = (bf16_t*)(ws + WS_YAB); const float* ssqb = (const float*)(ws + WS_SSQB);
            for (int row = (bx - 128) * NWAVES + wave; row < T; row += (G - 128) * NWAVES) {
                const float rs = row_rstd(ssqb, row);
                u32x2* p = (u32x2*)(yab + (size_t)row * 1536) + lane;
#pragma unroll
                for (int j = 0; j < 4; ++j) { u32x2 w = p[64 * j]; w.x = pk2(bflo(w.x) * rs, bfhi(w.x) * rs); w.y = pk2(bflo(w.y) * rs, bfhi(w.y) * rs); p[64 * j] = w; }
            }
        }
    }
    SEAM(4);
    if (IN(5)) {
        OrdStd S; S.init(ws + WS_YAB, ws + WS_W0OUT, 1536, 1536, T, 1024, 1536, G, bx);
        const GDesc gd{1536, 1536, 128L * 1536 * 2, 128L * 1536 * 2};
        EpiRes E{args.in[0], hres, hb, ssq};
        gemm_phase<EpiRes, OrdStd, true>(lds, gd, S, E);
    }
    SEAM(5);
    if (IN(6)) {
        LAS float* scr = (LAS float*)(lds + wave * 16384);
        { FIn1 f{args.in[22], args.in[1] + 1024}; transpose_all(f, (bf16_t*)(ws + WS_W1IN), 1024, 4096, scr, lane, gw, NGW); }
        { FAlr f{args.in[22], args.in[1] + 1024}; transpose_all(f, (bf16_t*)(ws + WS_W1ALR), 1024, 32, scr, lane, gw, NGW); }
        { FGate f{args.in[22], args.in[1] + 1024}; transpose_all(f, (bf16_t*)(ws + WS_W1GT), 1024, 2048, scr, lane, gw, NGW); }
        { FOut1 f{args.in[27], args.in[23], args.in[26]}; transpose_all(f, (bf16_t*)(ws + WS_W1OUT), 2048, 1024, scr, lane, gw, NGW); }
        { FGu f{args.in[28] + (size_t)1024 * FFH, args.in[29] + (size_t)1024 * FFH, args.in[2] + 1024}; transpose_all(f, (bf16_t*)(ws + WS_W1GU), 1024, 5632, scr, lane, gw, NGW); }
        { FPlain f{args.in[30] + (size_t)FFH * 1024, 1024}; transpose_all(f, (bf16_t*)(ws + WS_W1DN), FFH, 1024, scr, lane, gw, NGW); }
        __syncthreads();
        OrdStd S; S.init(hb, ws + WS_W0GU, 1024, 1024, T, 5632, 1024, G, bx);
        const GDesc gd{1024, 1024, 128L * 1024 * 2, 128L * 1024 * 2};
        EpiGu E{ssq, (bf16_t*)(ws + WS_HID0)};
        gemm_phase<EpiGu, OrdStd, true>(lds, gd, S, E);
    }
    SEAM(6);
    if (IN(7)) {
        OrdStd S; S.init(ws + WS_HID0, ws + WS_W0DN, FFH, FFH, T, 1024, FFH, G, bx);
        const GDesc gd{FFH, FFH, 128L * FFH * 2, 128L * FFH * 2};
        EpiRes E{hres, hres, hb, ssq};
        gemm_phase<EpiRes, OrdStd, true>(lds, gd, S, E);
    }
    SEAM(7);
    if (IN(8)) {
        skinny16(hb, (const bf16_t*)(ws + WS_W1ALR), ssq, (float*)(ws + WS_ALR1), gw, NGW, lane);
        OrdStd S; S.init(hb, ws + WS_W1IN, 1024, 1024, T, 4096, 1024, G, bx);
        const GDesc gd{1024, 1024, 128L * 1024 * 2, 128L * 1024 * 2};
        EpiIn1 E{ssq, (const float*)(ws + WS_ROT), (bf16_t*)(ws + WS_QKV)};
        gemm_phase<EpiIn1, OrdStd, true>(lds, gd, S, E);
    }
    SEAM(8);
    if (IN(9)) {
        bf16_t* qkv = (bf16_t*)(ws + WS_QKV); const float* alr = (const float*)(ws + WS_ALR1);
        for (int task = gw; task < 1024; task += NGW) {
            const int mixer = task >> 9, b = (task >> 6) & 7, h = (task >> 4) & 3, vb = task & 15;
            const int vl = lane >> 2, dq = lane & 3, vcol = h * 256 + vb * 16 + vl;
            const int qoff = (mixer ? 1024 : 0) + h * 128 + dq * 32, koff = qoff + 512, voff = 2048 + (mixer ? 1024 : 0) + vcol;
            float S[32];
#pragma unroll
            for (int j = 0; j < 32; ++j) S[j] = 0.f;
            const float gam = 1.0f - exp2f(-5.0f - (float)h);
            float gw0[16], gw1[16], gb0 = 0.f, gb1 = 0.f;
            if (mixer) {
#pragma unroll
                for (int r = 0; r < 16; ++r) { gw0[r] = args.in[24][r * 512 + h * 128 + lane]; gw1[r] = args.in[24][r * 512 + h * 128 + 64 + lane]; }
                gb0 = args.in[25][h * 128 + lane]; gb1 = args.in[25][h * 128 + 64 + lane];
            } else {
#pragma unroll
                for (int r = 0; r < 16; ++r) { gw0[r] = 0.f; gw1[r] = 0.f; }
            }
            for (int t = 0; t < SEQ; ++t) {
                const size_t row = (size_t)b * SEQ + t; const bf16_t* rp = qkv + row * 4096;
                u32x4 qw[4], kw[4];
#pragma unroll
                for (int j = 0; j < 4; ++j) { qw[j] = *(const u32x4*)(rp + qoff + 8 * j); kw[j] = *(const u32x4*)(rp + koff + 8 * j); }
                const float vv = bf2f(rp[voff]);
                float a_lo = gam, a_hi = gam;
                if (mixer) {
                    const f32x4* ar = (const f32x4*)(alr + row * 16); const f32x4 r0 = ar[0], r1 = ar[1], r2 = ar[2], r3 = ar[3];
                    float z0 = gb0, z1 = gb1;
#pragma unroll
                    for (int r = 0; r < 4; ++r) { z0 += r0[r] * gw0[r] + r1[r] * gw0[4 + r] + r2[r] * gw0[8 + r] + r3[r] * gw0[12 + r]; z1 += r0[r] * gw1[r] + r1[r] * gw1[4 + r] + r2[r] * gw1[8 + r] + r3[r] * gw1[12 + r]; }
                    a_lo = expf((fminf(z0, 0.f) - log1pf(expf(-fabsf(z0)))) * 0.0625f); a_hi = expf((fminf(z1, 0.f) - log1pf(expf(-fabsf(z1)))) * 0.0625f);
                }
                float o = 0.f;
#pragma unroll
                for (int j = 0; j < 32; ++j) {
                    const unsigned qq = (j & 4) ? ((j & 2) ? qw[j >> 3].w : qw[j >> 3].z) : ((j & 2) ? qw[j >> 3].y : qw[j >> 3].x);
                    const unsigned kk = (j & 4) ? ((j & 2) ? kw[j >> 3].w : kw[j >> 3].z) : ((j & 2) ? kw[j >> 3].y : kw[j >> 3].x);
                    const float qv = (j & 1) ? bfhi(qq) : bflo(qq), kv = (j & 1) ? bfhi(kk) : bflo(kk);
                    float a = gam;
                    if (mixer) { const int d = dq * 32 + j; const float al = __shfl(a_lo, d & 63), ah = __shfl(a_hi, d & 63); a = (dq & 2) ? ah : al; }
                    S[j] = a * S[j] + kv * vv; o += qv * S[j];
                }
                o += __shfl_xor(o, 1); o += __shfl_xor(o, 2);
                if (dq == 0) qkv[row * 4096 + voff] = (bf16_t)f2bf(o);
            }
        }
    }
    SEAM(9);
    if (IN(10)) {
        bf16_t* qkv = (bf16_t*)(ws + WS_QKV);
        for (int task = gw; task < T * 8; task += NGW) {
            const int row = task >> 3, hs = task & 7;
            u32x2* p = (u32x2*)(qkv + (size_t)row * 4096 + 2048 + hs * 256) + lane;
            const u32x2 w = *p; const float v0 = bflo(w.x), v1 = bfhi(w.x), v2 = bflo(w.y), v3 = bfhi(w.y);
            const float s1 = wave_sum((v0 + v1) + (v2 + v3)), s2 = wave_sum((v0 * v0 + v1 * v1) + (v2 * v2 + v3 * v3));
            float mu = 0.f, rs;
            if (hs < 4) { mu = s1 * (1.f / 256.f); const float var = fmaxf(s2 * (1.f / 256.f) - mu * mu, 0.f); rs = rsqrtf(var + EPS); }
            else rs = rsqrtf(s2 * (1.f / 256.f) + EPS);
            u32x2 o; o.x = pk2((v0 - mu) * rs, (v1 - mu) * rs); o.y = pk2((v2 - mu) * rs, (v3 - mu) * rs); *p = o;
        }
    }
    SEAM(10);
    if (IN(11)) {
        OrdStd S; S.init(hb, ws + WS_W1GT, 1024, 1024, T, 2048, 1024, G, bx);
        const GDesc gd{1024, 1024, 128L * 1024 * 2, 128L * 1024 * 2};
        EpiGate E{ssq, (bf16_t*)(ws + WS_QKV)};
        gemm_phase<EpiGate, OrdStd, true>(lds, gd, S, E);
    }
    SEAM(11);
    if (IN(12)) {
        OrdStd S; S.init(ws + WS_QKV + 2048 * 2, ws + WS_W1OUT, 4096, 2048, T, 1024, 2048, G, bx);
        const GDesc gd{4096, 2048, 128L * 4096 * 2, 128L * 2048 * 2};
        EpiRes E{hres, hres, hb, ssq};
        gemm_phase<EpiRes, OrdStd, true>(lds, gd, S, E);
    }
    SEAM(12);
    if (IN(13)) {
        OrdStd S; S.init(hb, ws + WS_W1GU, 1024, 1024, T, 5632, 1024, G, bx);
        const GDesc gd{1024, 1024, 128L * 1024 * 2, 128L * 1024 * 2};
        EpiGu E{ssq, (bf16_t*)(ws + WS_HID1)};
        gemm_phase<EpiGu, OrdStd, true>(lds, gd, S, E);
    }
    SEAM(13);
    if (IN(14)) {
        OrdStd S; S.init(ws + WS_HID1, ws + WS_W1DN, FFH, FFH, T, 1024, FFH, G, bx);
        const GDesc gd{FFH, FFH, 128L * FFH * 2, 128L * FFH * 2};
        EpiRes E{hres, hres, hb, ssq};
        gemm_phase<EpiRes, OrdStd, true>(lds, gd, S, E);
    }
    SEAM(14);
    if (IN(15)) {
        const float* fg = args.in[3];
        for (int row = gw; row < T; row += NGW) {
            const float rs = row_rstd(ssq, row);
            f32x4* p = (f32x4*)(hres + (size_t)row * 1024) + lane; const f32x4* gp = (const f32x4*)fg + lane;
#pragma unroll
            for (int j = 0; j < 4; ++j) p[64 * j] = p[64 * j] * rs * gp[64 * j];
        }
    }
#undef IN
#undef SEAM
}

extern "C" void kernel_launch(void* const* d_in, const int* in_sizes, int n_in, void* d_out, int out_size, void* d_ws, size_t ws_size, hipStream_t stream) {
    static int grid = 0;
    if (grid == 0) {
        if (n_in != 31 || out_size != T * DM || ws_size < WS_END) { fprintf(stderr, "kernel_launch: unexpected problem (n_in %d, out %d, ws %zu)\n", n_in, out_size, ws_size); grid = -1; return; }
        int dev = 0, cus = 0, per_cu = 0;
        if (hipGetDevice(&dev) != hipSuccess || hipDeviceGetAttribute(&cus, hipDeviceAttributeMultiprocessorCount, dev) != hipSuccess) { grid = -1; return; }
        if (hipFuncSetAttribute((const void*)mega_fwd, hipFuncAttributeMaxDynamicSharedMemorySize, LDS_BYTES) != hipSuccess) { fprintf(stderr, "kernel_launch: hipFuncSetAttribute failed\n"); grid = -1; return; }
        if (hipOccupancyMaxActiveBlocksPerMultiprocessor(&per_cu, (const void*)mega_fwd, NTHREADS, LDS_BYTES) != hipSuccess || per_cu < 1) { fprintf(stderr, "kernel_launch: occupancy query says %d blocks per CU\n", per_cu); grid = -1; (void)hipGetLastError(); return; }
        grid = cus;
    }
    if (grid < 0) return;
    (void)hipMemsetAsync((char*)d_ws + WS_CTL, 0, CTL_ZERO_BYTES, stream);
    Args a{};
    for (int i = 0; i < 31; ++i) a.in[i] = (const float*)d_in[i];
    a.out = (float*)d_out; a.ws = (unsigned char*)d_ws;
#if MK_PER_PHASE
    for (int p = 0; p < NPH; ++p) { a.ph_lo = p; a.ph_hi = p + 1; hipLaunchKernelGGL(mega_fwd, dim3(grid), dim3(NTHREADS), LDS_BYTES, stream, a); }
#else
    a.ph_lo = 0; a.ph_hi = NPH;
    void* kargs[] = {&a};
    hipError_t e = hipLaunchCooperativeKernel((const void*)mega_fwd, dim3(grid), dim3(NTHREADS), kargs, LDS_BYTES, stream);
    if (e != hipSuccess) fprintf(stderr, "kernel_launch: cooperative launch failed: %s (grid %d)\n", hipGetErrorString(e), grid);
#endif
}
```

```cpp
#include <hip/hip_runtime.h>
#include <cstdio>
#include <cstdint>

#ifndef MK_PER_PHASE
#define MK_PER_PHASE 0
#endif

#define GAS __attribute__((address_space(1)))
#define LAS __attribute__((address_space(3)))
typedef unsigned short bf16_t;
typedef short bf16x8 __attribute__((ext_vector_type(8)));
typedef float f32x4 __attribute__((ext_vector_type(4)));
typedef float f32x2 __attribute__((ext_vector_type(2)));
typedef unsigned u32x4 __attribute__((ext_vector_type(4)));
typedef unsigned u32x2 __attribute__((ext_vector_type(2)));

constexpr int NB = 8, SEQ = 2048, DM = 1024, T = NB * SEQ;
constexpr int EVEN_IN = 3088, ODD_IN = 6160, FFH = 2816;
constexpr float EPS = 1e-6f;
constexpr int NWAVES = 8, NTHREADS = 512;

constexpr size_t MiB = 1u << 20;
constexpr size_t WS_CTL = 0, CTL_ZERO_BYTES = 65536;
constexpr size_t WS_SSQ = 1 * MiB;
constexpr size_t WS_SSQB = 2 * MiB;
constexpr size_t WS_DT = 4 * MiB;
constexpr size_t WS_ROT = 5 * MiB;
constexpr size_t WS_A64 = 6 * MiB;
constexpr size_t WS_HB = 7 * MiB;
constexpr size_t WS_W0IN = 39 * MiB;
constexpr size_t WS_W0DT = 45 * MiB;
constexpr size_t WS_W0GLU = 45 * MiB + 512 * 1024;
constexpr size_t WS_W0OUT = 46 * MiB;
constexpr size_t WS_W0GU = 49 * MiB;
constexpr size_t WS_W0DN = 60 * MiB;
constexpr size_t WS_S5BC = 66 * MiB;
constexpr size_t WS_S5W1 = 90 * MiB;
constexpr size_t WS_UPERM = 98 * MiB;
constexpr size_t WS_ZS = 116 * MiB;
constexpr size_t WS_XBC = 148 * MiB;
constexpr size_t WS_YAB = 196 * MiB;
constexpr size_t WS_ZG = WS_HB;
constexpr size_t WS_HID0 = 148 * MiB;
constexpr size_t WS_W1IN = 66 * MiB;
constexpr size_t WS_W1ALR = 74 * MiB;
constexpr size_t WS_W1GT = 74 * MiB + 512 * 1024;
constexpr size_t WS_W1OUT = 79 * MiB;
constexpr size_t WS_W1GU = 83 * MiB;
constexpr size_t WS_W1DN = 94 * MiB;
constexpr size_t WS_QKV = 100 * MiB;
constexpr size_t WS_HID1 = 100 * MiB;
constexpr size_t WS_LOGA = 39 * MiB;
constexpr size_t WS_END = 256 * MiB;

constexpr int CW_BAR = 4096;

__device__ __forceinline__ unsigned f2bf(float f) { unsigned u = __float_as_uint(f); return (u + 0x7fffu + ((u >> 16) & 1u)) >> 16; }
__device__ __forceinline__ unsigned pk2(float lo, float hi) { return f2bf(lo) | (f2bf(hi) << 16); }
__device__ __forceinline__ float bf2f(unsigned h) { return __uint_as_float(h << 16); }
__device__ __forceinline__ float bflo(unsigned w) { return __uint_as_float(w << 16); }
__device__ __forceinline__ float bfhi(unsigned w) { return __uint_as_float(w & 0xffff0000u); }
typedef __bf16 bf16v2 __attribute__((ext_vector_type(2)));
__device__ __forceinline__ unsigned cvt_pk_bf16(float lo, float hi) { const f32x2 v = {lo, hi}; const bf16v2 r = __builtin_convertvector(v, bf16v2); return __builtin_bit_cast(unsigned, r); }
__device__ __forceinline__ float wave_sum(float v) {
#pragma unroll
    for (int o = 1; o < 64; o <<= 1) v += __shfl_xor(v, o);
    return v;
}
__device__ __forceinline__ float sigmoidf_(float x) { return 1.0f / (1.0f + __expf(-x)); }
__device__ __forceinline__ float siluf_(float x) { return x / (1.0f + __expf(-x)); }
__device__ __forceinline__ float gelu_tanh(float x) { const float u = 1.5957691216f * (x + 0.044715f * x * x * x); return x / (1.0f + __expf(-u)); }
__device__ __forceinline__ float ld_coh(const float* p) { return __hip_atomic_load(p, __ATOMIC_RELAXED, __HIP_MEMORY_SCOPE_AGENT); }
#define LDS_WAIT() asm volatile("s_waitcnt lgkmcnt(0)" ::: "memory")
#define VM_WAIT() asm volatile("s_waitcnt vmcnt(0)" ::: "memory")

__device__ __forceinline__ float row_rstd(const float* ssq, int row) {
    const f32x4* p = (const f32x4*)(ssq + (size_t)row * 16);
    const f32x4 a = p[0], b = p[1], c = p[2], d = p[3];
    const float s = ((a.x + a.y) + (a.z + a.w)) + ((b.x + b.y) + (b.z + b.w)) + ((c.x + c.y) + (c.z + c.w)) + ((d.x + d.y) + (d.z + d.w));
    return rsqrtf(s * (1.0f / 1024.0f) + EPS);
}

constexpr int BM = 256, BK = 64, HALF = 128, HTB = HALF * BK * 2, STAGE_BYTES = 8 * HTB;
__device__ __forceinline__ int lds_byte(int r, int c) { const int st = (r >> 4) * 2 + (c >> 5), rr = r & 15, cc = c & 31, ob = rr * 64 + cc * 2; return st * 1024 + (ob ^ (((ob >> 9) & 1) << 5)); }
__device__ __forceinline__ void stage_rc(int b, int& R, int& C) { const int st = b / 1024, sb = b % 1024, swz = sb ^ (((sb >> 9) & 1) << 5); R = (st >> 1) * 16 + swz / 64; C = (st & 1) * 32 + (swz % 64) / 2; }
__device__ __forceinline__ int perm32(int rho) { const int n = rho >> 4, i = rho & 15; return 8 * (i >> 2) + 4 * n + (i & 3); }

struct Unit { const char* a; const char* b; long bjump; int pm, pn, nt, aux; };
struct GDesc { int lda, ldb; long hsA, hsB; };

struct OrdStd {
    const char* A; const char* B; int lda, ldb, nM, nN, nwg, G, c, nt;
    __device__ void init(const void* A_, const void* B_, int lda_, int ldb_, int M, int N, int K, int G_, int c_) { A = (const char*)A_; B = (const char*)B_; lda = lda_; ldb = ldb_; nM = M / BM; nN = N / BM; nwg = nM * nN; G = G_; c = c_; nt = K / BK; }
    __device__ bool next(int i, Unit& u) const {
        const long L = (long)i * G + c; if (c < 0 || L >= nwg) return false;
        int wgid = (int)L; { const int q = nwg / 8, r = nwg % 8, xcd = wgid % 8, off = wgid / 8; wgid = (xcd < r ? xcd * (q + 1) : r * (q + 1) + (xcd - r) * q) + off; }
        const int nig = 8 * nN, gid = wgid / nig, fm = gid * 8, gsz = (nM - fm) < 8 ? (nM - fm) : 8;
        u.pm = fm + ((wgid % nig) % gsz); u.pn = (wgid % nig) / gsz; u.nt = nt; u.bjump = 0; u.aux = 0;
        u.a = A + (size_t)u.pm * BM * lda * 2; u.b = B + (size_t)u.pn * BM * ldb * 2; return true;
    }
    __device__ __forceinline__ void a_ready(const Unit&) const {}
    __device__ __forceinline__ void done(const Unit&) const {}
};

template <class Epi, class Sched, bool ALIGN_EPI>
__device__ __forceinline__ void gemm_phase(LAS unsigned char* lds, const GDesc g, const Sched& S, const Epi& E) {
    const int tid = threadIdx.x, wid = __builtin_amdgcn_readfirstlane(tid >> 6), lane = tid & 63, wr = wid >> 2, wc = wid & 3, fr = lane & 15, fq = lane >> 4;
    unsigned voffA[2], voffB[2];
#pragma unroll
    for (int i = 0; i < 2; ++i) { int R, C; stage_rc(tid * 16 + i * 8192, R, C); const int Rb = Epi::PERM ? ((R & ~31) + perm32(R & 31)) : R;
        voffA[i] = (unsigned)(R * g.lda + C) * 2u; voffB[i] = (unsigned)(Rb * g.ldb + C) * 2u; }
    const long kstep = BK * 2;
    const long hsA = g.hsA, hsB = g.hsB;
    const unsigned ldsw = (unsigned)wid * 1024u;
    const int aoff = lds_byte(wr * 64 + fr, fq * 8), boff = lds_byte(wc * 32 + fr, fq * 8);
#define PG8_SA(b, h) (((b) * 2 + (h)) * HTB)
#define PG8_SB(b, h) ((4 + (b) * 2 + (h)) * HTB)
#define PG8_STAGE(bufoff, gbase, voff) do { _Pragma("unroll") for (int _i = 0; _i < 2; ++_i) \
        __builtin_amdgcn_global_load_lds((const unsigned*)((const char*)(gbase) + (voff)[_i]), (LAS unsigned*)(lds + (bufoff) + ldsw + _i * 8192), 16, 0, 0); } while (0)
#define PG8_LDA(dst, b, h) do { _Pragma("unroll") for (int m = 0; m < 4; ++m) _Pragma("unroll") for (int k = 0; k < 2; ++k) dst[m][k] = *(const LAS bf16x8*)(lds + PG8_SA(b, h) + aoff + m * 2048 + k * 1024); } while (0)
#define PG8_LDB(dst, b, h) do { _Pragma("unroll") for (int n = 0; n < 2; ++n) _Pragma("unroll") for (int k = 0; k < 2; ++k) dst[n][k] = *(const LAS bf16x8*)(lds + PG8_SB(b, h) + boff + n * 2048 + k * 1024); } while (0)
#define PG8_MMA(ai, bj, At, Bt) do { __builtin_amdgcn_s_setprio(1); _Pragma("unroll") for (int m = 0; m < 4; ++m) _Pragma("unroll") for (int n = 0; n < 2; ++n) _Pragma("unroll") for (int k = 0; k < 2; ++k) \
        acc[ai][bj][m][n] = __builtin_amdgcn_mfma_f32_16x16x32_bf16(Bt[n][k], At[m][k], acc[ai][bj][m][n], 0, 0, 0); __builtin_amdgcn_s_setprio(0); } while (0)
#define PG8_WAIT_V(n) asm volatile("s_waitcnt vmcnt(" #n ")" ::: "memory")
#define PG8_WAIT_L(n) asm volatile("s_waitcnt lgkmcnt(" #n ")" ::: "memory")
#define PG8_BAR __builtin_amdgcn_s_barrier()
#define PG8_SCHED __builtin_amdgcn_sched_barrier(0)
    Unit cur, nxt; int ui = 0;
    if (!S.next(0, cur)) return;
    f32x4 acc[2][2][4][2];
#pragma unroll
    for (int a = 0; a < 2; ++a)
#pragma unroll
        for (int b = 0; b < 2; ++b)
#pragma unroll
            for (int m = 0; m < 4; ++m)
#pragma unroll
                for (int n = 0; n < 2; ++n) acc[a][b][m][n] = (f32x4){0.f, 0.f, 0.f, 0.f};
    bf16x8 At[4][2], B0[2][2], B1[2][2];
    const char* cA = cur.a; const char* cB = cur.b;
    S.a_ready(cur);
    PG8_STAGE(PG8_SB(0, 0), cB, voffB); PG8_STAGE(PG8_SB(0, 1), cB + hsB, voffB); PG8_STAGE(PG8_SA(0, 0), cA, voffA); PG8_STAGE(PG8_SA(0, 1), cA + hsA, voffA);
    if (wr == 1) PG8_BAR;
    PG8_WAIT_V(2); PG8_BAR;
    PG8_STAGE(PG8_SB(1, 0), cB + kstep, voffB); PG8_STAGE(PG8_SA(1, 0), cA + kstep, voffA); PG8_STAGE(PG8_SB(1, 1), cB + hsB + kstep, voffB);
    PG8_WAIT_V(6); PG8_BAR;
    for (;;) {
        const bool has_next = S.next(ui + 1, nxt);
        const char* nA = has_next ? nxt.a : cA; const char* nB = has_next ? nxt.b : cB;
        const int nt = cur.nt; const long bjump = cur.bjump;
        for (int t = 0; t < nt; t += 2) {
            const bool last = (t == nt - 2);
            const char* a1 = cA + (size_t)(t + 1) * kstep;
            const char* a2 = last ? nA : cA + (size_t)(t + 2) * kstep; const char* b2 = last ? nB : cB + (size_t)(t + 2) * kstep + bjump;
            const char* a3 = a2 + kstep; const char* b3 = b2 + kstep;
            if (last && has_next) S.a_ready(nxt);
            PG8_LDB(B0, 0, 0); PG8_LDB(B1, 0, 1); PG8_SCHED; PG8_LDA(At, 0, 0); PG8_STAGE(PG8_SA(1, 1), a1 + hsA, voffA);
            PG8_WAIT_V(8); PG8_WAIT_L(0); PG8_BAR; PG8_MMA(0, 0, At, B0); PG8_MMA(0, 1, At, B1); PG8_BAR; PG8_SCHED;
            PG8_LDA(At, 0, 1); PG8_STAGE(PG8_SB(0, 0), b2, voffB); PG8_STAGE(PG8_SB(0, 1), b2 + hsB, voffB); PG8_STAGE(PG8_SA(0, 0), a2, voffA);
            PG8_WAIT_V(8); PG8_WAIT_L(0); PG8_BAR; PG8_MMA(1, 0, At, B0); PG8_MMA(1, 1, At, B1); PG8_BAR; PG8_SCHED;
            PG8_LDB(B0, 1, 0); PG8_LDB(B1, 1, 1); PG8_SCHED; PG8_LDA(At, 1, 0); PG8_STAGE(PG8_SA(0, 1), a2 + hsA, voffA);
            PG8_WAIT_V(8); PG8_WAIT_L(0); PG8_BAR; PG8_MMA(0, 0, At, B0); PG8_MMA(0, 1, At, B1); PG8_BAR; PG8_SCHED;
            PG8_LDA(At, 1, 1); PG8_STAGE(PG8_SB(1, 0), b3, voffB); PG8_STAGE(PG8_SB(1, 1), b3 + hsB, voffB); PG8_STAGE(PG8_SA(1, 0), a3, voffA);
            PG8_WAIT_V(8); PG8_WAIT_L(0); PG8_BAR; PG8_MMA(1, 0, At, B0); PG8_MMA(1, 1, At, B1); PG8_BAR; PG8_SCHED;
        }
        if constexpr (ALIGN_EPI) { if (wr == 0) PG8_BAR; }
        if constexpr (!Epi::AFTER_DRAIN) { E(acc, cur, wr, wc, fr, fq); S.done(cur); }
        if (!has_next) break;
#pragma unroll
        for (int a = 0; a < 2; ++a)
#pragma unroll
            for (int b = 0; b < 2; ++b)
#pragma unroll
                for (int m = 0; m < 4; ++m)
#pragma unroll
                    for (int n = 0; n < 2; ++n) acc[a][b][m][n] = (f32x4){0.f, 0.f, 0.f, 0.f};
        cur = nxt; cA = nA; cB = nB; ++ui;
        if constexpr (ALIGN_EPI) { if (wr == 1) PG8_BAR; }
    }
    PG8_WAIT_V(0);
    if constexpr (!ALIGN_EPI) { if (wr == 0) PG8_BAR; }
    PG8_BAR;
    if constexpr (Epi::AFTER_DRAIN) { E.fused(acc, cur, wr, wc, fr, fq, lds, wid, lane); S.done(cur); }
#undef PG8_SA
#undef PG8_SB
#undef PG8_STAGE
#undef PG8_LDA
#undef PG8_LDB
#undef PG8_MMA
#undef PG8_WAIT_V
#undef PG8_WAIT_L
#undef PG8_BAR
#undef PG8_SCHED
}

__device__ __forceinline__ u32x4 pack8(const f32x4 v0, const f32x4 v1) { u32x4 w; w.x = cvt_pk_bf16(v0[0], v0[1]); w.y = cvt_pk_bf16(v0[2], v0[3]); w.z = cvt_pk_bf16(v1[0], v1[1]); w.w = cvt_pk_bf16(v1[2], v1[3]); return w; }

struct EpiIn0 {
    static constexpr bool PERM = true, AFTER_DRAIN = false;
    const float* ssq; bf16_t* uperm; bf16_t* zs; bf16_t* xbc;
    __device__ __forceinline__ void operator()(const f32x4 (&acc)[2][2][4][2], const Unit& u, int wr, int wc, int fr, int fq) const {
#pragma unroll
        for (int ai = 0; ai < 2; ++ai)
#pragma unroll
            for (int m = 0; m < 4; ++m) {
                const int row = u.pm * BM + ai * HALF + wr * 64 + m * 16 + fr; const float rs = row_rstd(ssq, row);
#pragma unroll
                for (int bj = 0; bj < 2; ++bj) {
                    const int c = u.pn * BM + bj * HALF + wc * 32 + 8 * fq;
                    const u32x4 w = pack8(acc[ai][bj][m][0] * rs, acc[ai][bj][m][1] * rs);
                    bf16_t* dst;
                    if (u.pn < 2) { const int g = c >> 4, m0 = c & 15; dst = uperm + ((size_t)(g * 256 + (row >> 6)) * 1152 + 128 + (row & 63) * 16 + m0); }
                    else if (u.pn < 6) dst = zs + (size_t)row * 1024 + (c - 512);
                    else dst = xbc + (size_t)row * 1536 + (c - 1536);
                    *(u32x4*)dst = w;
                }
            }
    }
};
struct EpiS5A {
    static constexpr bool PERM = false, AFTER_DRAIN = true;
    bf16_t* uperm; const float* a64;
    __device__ __forceinline__ void operator()(const f32x4 (&)[2][2][4][2], const Unit&, int, int, int, int) const {}
    __device__ __forceinline__ void fused(f32x4 (&acc)[2][2][4][2], const Unit& u, int wr, int wc, int fr, int fq, LAS unsigned char* lds, int wid, int lane) const {
        LAS float* S = (LAS float*)lds;
#pragma unroll
        for (int ai = 0; ai < 2; ++ai)
#pragma unroll
            for (int m = 0; m < 4; ++m) { const int r = ai * HALF + wr * 64 + m * 16 + fr;
#pragma unroll
                for (int n = 0; n < 2; ++n) *(LAS f32x4*)(S + r * 128 + wc * 32 + n * 16 + 4 * fq) = acc[ai][0][m][n]; }
        LDS_WAIT(); __syncthreads();
        const int g = u.aux, tid = wid * 64 + lane, b = tid >> 6, p = tid & 63;
        const f32x2 a = *(const f32x2*)(a64 + (size_t)(g * 64 + p) * 2);
        float xr = 0.f, xi = 0.f;
        for (int c = 0; c < 32; ++c) {
            const int r = b * 32 + c;
            bf16_t* dst = uperm + (size_t)(g * 256 + r) * 1152;
            dst[p] = (bf16_t)f2bf(xr); dst[64 + p] = (bf16_t)f2bf(xi);
            const float sr = S[r * 128 + p], si = S[r * 128 + 64 + p];
            const float nr = a.x * xr - a.y * xi + sr, ni = a.x * xi + a.y * xr + si;
            xr = nr; xi = ni;
        }
        __syncthreads();
    }
};
struct EpiS5C {
    static constexpr bool PERM = true, AFTER_DRAIN = false;
    bf16_t* zg;
    __device__ __forceinline__ void operator()(const f32x4 (&acc)[2][2][4][2], const Unit& u, int wr, int wc, int fr, int fq) const {
        const int g = u.aux >> 2, i = u.aux & 3;
#pragma unroll
        for (int ai = 0; ai < 2; ++ai)
#pragma unroll
            for (int m = 0; m < 4; ++m) {
                const int r = ai * HALF + wr * 64 + m * 16 + fr;
#pragma unroll
                for (int bj = 0; bj < 2; ++bj) {
                    const int ct = bj * HALF + wc * 32 + 8 * fq, tp = ct >> 4, n0 = ct & 15;
                    f32x4 v0 = acc[ai][bj][m][0], v1 = acc[ai][bj][m][1];
#pragma unroll
                    for (int j = 0; j < 4; ++j) { v0[j] = gelu_tanh(v0[j]); v1[j] = gelu_tanh(v1[j]); }
                    *(u32x4*)(zg + ((size_t)(r * 64 + 16 * i + tp) * 512 + g * 16 + n0)) = pack8(v0, v1);
                }
            }
    }
};
struct EpiGlu {
    static constexpr bool PERM = true, AFTER_DRAIN = false;
    const bf16_t* zg; const float* bias; bf16_t* yab;
    __device__ __forceinline__ void operator()(const f32x4 (&acc)[2][2][4][2], const Unit& u, int wr, int wc, int fr, int fq) const {
#pragma unroll
        for (int bj = 0; bj < 2; ++bj) {
            const int c = u.pn * BM + bj * HALF + wc * 32 + 8 * fq;
            const f32x4 b0 = *(const f32x4*)(bias + c), b1 = *(const f32x4*)(bias + c + 4);
#pragma unroll
            for (int ai = 0; ai < 2; ++ai)
#pragma unroll
                for (int m = 0; m < 4; ++m) {
                    const int row = u.pm * BM + ai * HALF + wr * 64 + m * 16 + fr;
                    const u32x4 zw = *(const u32x4*)(zg + (size_t)row * 512 + c);
                    f32x4 v0 = acc[ai][bj][m][0] + b0, v1 = acc[ai][bj][m][1] + b1;
                    v0[0] = bflo(zw.x) * sigmoidf_(v0[0]); v0[1] = bfhi(zw.x) * sigmoidf_(v0[1]); v0[2] = bflo(zw.y) * sigmoidf_(v0[2]); v0[3] = bfhi(zw.y) * sigmoidf_(v0[3]);
                    v1[0] = bflo(zw.z) * sigmoidf_(v1[0]); v1[1] = bfhi(zw.z) * sigmoidf_(v1[1]); v1[2] = bflo(zw.w) * sigmoidf_(v1[2]); v1[3] = bfhi(zw.w) * sigmoidf_(v1[3]);
                    *(u32x4*)(yab + (size_t)row * 1536 + 1024 + c) = pack8(v0, v1);
                }
        }
    }
};
struct EpiRes {
    static constexpr bool PERM = false, AFTER_DRAIN = false;
    const float* hin; float* hout; bf16_t* hb; float* ssq;
    __device__ __forceinline__ void operator()(const f32x4 (&acc)[2][2][4][2], const Unit& u, int wr, int wc, int fr, int fq) const {
#pragma unroll
        for (int ai = 0; ai < 2; ++ai)
#pragma unroll
            for (int m = 0; m < 4; ++m) {
                const int row = u.pm * BM + ai * HALF + wr * 64 + m * 16 + fr; float ss = 0.f;
#pragma unroll
                for (int bj = 0; bj < 2; ++bj)
#pragma unroll
                    for (int n = 0; n < 2; ++n) {
                        const size_t off = (size_t)row * 1024 + u.pn * BM + bj * HALF + wc * 32 + n * 16 + 4 * fq;
                        const f32x4 h = *(const f32x4*)(hin + off) + acc[ai][bj][m][n];
                        *(f32x4*)(hout + off) = h;
                        u32x2 w; w.x = cvt_pk_bf16(h[0], h[1]); w.y = cvt_pk_bf16(h[2], h[3]); *(u32x2*)(hb + off) = w;
                        ss += (h[0] * h[0] + h[1] * h[1]) + (h[2] * h[2] + h[3] * h[3]);
                    }
                ss += __shfl_xor(ss, 16); ss += __shfl_xor(ss, 32);
                if (fq == 0) ssq[(size_t)row * 16 + u.pn * 4 + wc] = ss;
            }
    }
};
struct EpiGu {
    static constexpr bool PERM = true, AFTER_DRAIN = false;
    const float* ssq; bf16_t* hid;
    __device__ __forceinline__ void operator()(const f32x4 (&acc)[2][2][4][2], const Unit& u, int wr, int wc, int fr, int fq) const {
#pragma unroll
        for (int ai = 0; ai < 2; ++ai)
#pragma unroll
            for (int m = 0; m < 4; ++m) {
                const int row = u.pm * BM + ai * HALF + wr * 64 + m * 16 + fr; const float rs = row_rstd(ssq, row);
#pragma unroll
                for (int bj = 0; bj < 2; ++bj) {
                    const f32x4 gt = acc[ai][bj][m][0] * rs, up = acc[ai][bj][m][1] * rs;
                    u32x2 w; w.x = cvt_pk_bf16(siluf_(gt[0]) * up[0], siluf_(gt[1]) * up[1]); w.y = cvt_pk_bf16(siluf_(gt[2]) * up[2], siluf_(gt[3]) * up[3]);
                    *(u32x2*)(hid + (size_t)row * FFH + u.pn * 128 + bj * 64 + wc * 16 + 4 * fq) = w;
                }
            }
    }
};
struct EpiIn1 {
    static constexpr bool PERM = true, AFTER_DRAIN = false;
    const float* ssq; const float* rot; bf16_t* qkv;
    __device__ __forceinline__ void operator()(const f32x4 (&acc)[2][2][4][2], const Unit& u, int wr, int wc, int fr, int fq) const {
#pragma unroll
        for (int ai = 0; ai < 2; ++ai)
#pragma unroll
            for (int m = 0; m < 4; ++m) {
                const int row = u.pm * BM + ai * HALF + wr * 64 + m * 16 + fr; const float rs = row_rstd(ssq, row);
#pragma unroll
                for (int bj = 0; bj < 2; ++bj) {
                    const int c = u.pn * BM + bj * HALF + wc * 32 + 8 * fq;
                    f32x4 v0 = acc[ai][bj][m][0] * rs, v1 = acc[ai][bj][m][1] * rs;
                    if (u.pn < 4) {
                        const int i0 = (c & 127) >> 1; const float* cs = rot + ((size_t)(row & 2047) * 64 + i0) * 2;
                        const f32x4 c0 = *(const f32x4*)cs, c1 = *(const f32x4*)(cs + 4);
                        f32x4 o0, o1;
                        o0[0] = v0[0] * c0[0] - v0[1] * c0[1]; o0[1] = v0[0] * c0[1] + v0[1] * c0[0];
                        o0[2] = v0[2] * c0[2] - v0[3] * c0[3]; o0[3] = v0[2] * c0[3] + v0[3] * c0[2];
                        o1[0] = v1[0] * c1[0] - v1[1] * c1[1]; o1[1] = v1[0] * c1[1] + v1[1] * c1[0];
                        o1[2] = v1[2] * c1[2] - v1[3] * c1[3]; o1[3] = v1[2] * c1[3] + v1[3] * c1[2];
                        v0 = o0; v1 = o1;
                    }
                    *(u32x4*)(qkv + (size_t)row * 4096 + c) = pack8(v0, v1);
                }
            }
    }
};
struct EpiGate {
    static constexpr bool PERM = true, AFTER_DRAIN = false;
    const float* ssq; bf16_t* qkv;
    __device__ __forceinline__ void operator()(const f32x4 (&acc)[2][2][4][2], const Unit& u, int wr, int wc, int fr, int fq) const {
#pragma unroll
        for (int ai = 0; ai < 2; ++ai)
#pragma unroll
            for (int m = 0; m < 4; ++m) {
                const int row = u.pm * BM + ai * HALF + wr * 64 + m * 16 + fr; const float rs = row_rstd(ssq, row);
#pragma unroll
                for (int bj = 0; bj < 2; ++bj) {
                    const int c = u.pn * BM + bj * HALF + wc * 32 + 8 * fq;
                    bf16_t* p = qkv + (size_t)row * 4096 + 2048 + c;
                    const u32x4 ow = *(const u32x4*)p;
                    f32x4 v0 = acc[ai][bj][m][0] * rs, v1 = acc[ai][bj][m][1] * rs;
                    v0[0] = bflo(ow.x) * siluf_(v0[0]); v0[1] = bfhi(ow.x) * siluf_(v0[1]); v0[2] = bflo(ow.y) * siluf_(v0[2]); v0[3] = bfhi(ow.y) * siluf_(v0[3]);
                    v1[0] = bflo(ow.z) * siluf_(v1[0]); v1[1] = bfhi(ow.z) * siluf_(v1[1]); v1[2] = bflo(ow.w) * siluf_(v1[2]); v1[3] = bfhi(ow.w) * siluf_(v1[3]);
                    *(u32x4*)p = pack8(v0, v1);
                }
            }
    }
};

struct OrdS5A {
    const char* U; const char* W1; int c;
    __device__ bool next(int i, Unit& u) const {
        if (i != 0 || c < 0 || c >= 32) return false;
        u.pm = 0; u.pn = 0; u.nt = 16; u.bjump = 0; u.aux = c;
        u.a = U + ((size_t)c * 256 * 1152 + 128) * 2; u.b = W1 + (size_t)c * 128 * 1024 * 2; return true;
    }
    __device__ __forceinline__ void a_ready(const Unit&) const {}
    __device__ __forceinline__ void done(const Unit&) const {}
};
struct OrdS5C {
    const char* U; const char* BC; int c;
    __device__ bool next(int k, Unit& u) const {
        if (k != 0 || c < 0 || c >= 128) return false;
        const int g = c >> 2, i = 3 - (c & 3);
        u.pm = 0; u.pn = i; u.nt = 2 + 4 * (i + 1); u.bjump = -768L * (i + 1); u.aux = g * 4 + i;
        u.a = U + (size_t)g * 256 * 1152 * 2; u.b = BC + ((size_t)g * 256 * 1536 + 1024 + 128 * i) * 2; return true;
    }
    __device__ __forceinline__ void a_ready(const Unit&) const {}
    __device__ __forceinline__ void done(const Unit&) const {}
};

#define XB_TMO      128
#define XB_XCNT(j)  (256  + 64 * (j))
#define XB_XSUB(j)  (1280 + 64 * (j))
#define XB_XGEN(j)  (2304 + 64 * (j))
#define XB_TOP      3328
#define XB_TOPGEN   3392
#define XCD_BAR_WORDS 3456
#define XB_SPIN_CAP (1u << 18)
__device__ __forceinline__ unsigned xb_ld(unsigned* p)              { return __hip_atomic_load(p, __ATOMIC_RELAXED, __HIP_MEMORY_SCOPE_AGENT); }
__device__ __forceinline__ unsigned xb_add(unsigned* p, unsigned v) { return __hip_atomic_fetch_add(p, v, __ATOMIC_RELAXED, __HIP_MEMORY_SCOPE_AGENT); }
__device__ __forceinline__ unsigned xb_xcc_id() { return (unsigned)__builtin_amdgcn_s_getreg((3 << 11) | 20) & 0xFu; }
#define XB_SPIN(cond, bar) do { unsigned _sp = 0; while (cond) { __builtin_amdgcn_s_sleep(1); \
    if ((++_sp & 255u) == 0u) { if (xb_ld(&(bar)[XB_TMO])) break; if (_sp > XB_SPIN_CAP) { atomicAdd(&(bar)[XB_TMO], 1u); break; } } } } while (0)
struct XcdBarrier { unsigned* bar; unsigned x; volatile LAS unsigned* st; };
__device__ __forceinline__ XcdBarrier xcd_barrier_post(unsigned* bar, volatile LAS unsigned* st) {
    XcdBarrier b; b.bar = bar; b.x = xb_xcc_id(); b.st = st;
    if (threadIdx.x == 0) (void)xb_add(&bar[XB_XCNT(b.x)], 1u);
    return b;
}
__device__ __forceinline__ void xcd_barrier_complete(unsigned* bar, unsigned x, unsigned& nloc, unsigned& nx) {
    const unsigned G = gridDim.x * gridDim.y * gridDim.z;
    unsigned sum, cnt, mine, sp = 0u;
    for (;;) {
        sum = 0u; cnt = 0u; mine = 0u;
#pragma unroll
        for (unsigned j = 0; j < 16; ++j) { const unsigned c = xb_ld(&bar[XB_XCNT(j)]); sum += c; cnt += (c > 0u) ? 1u : 0u; mine = (j == x) ? c : mine; }
        if (sum == G) break;
        __builtin_amdgcn_s_sleep(1);
        if ((++sp & 255u) == 0u) { if (xb_ld(&bar[XB_TMO])) break; if (sp > XB_SPIN_CAP) { atomicAdd(&bar[XB_TMO], 1u); break; } }
    }
    nloc = mine > 0u ? mine : 1u; nx = cnt > 0u ? cnt : 1u;
}
__device__ __forceinline__ void xcd_barrier(const XcdBarrier& b) {
    asm volatile("s_waitcnt vmcnt(0)" ::: "memory");
    __syncthreads();
    if (threadIdx.x == 0) {
        unsigned* bar = b.bar;
        __builtin_amdgcn_s_waitcnt(0);
        unsigned nloc = b.st[0], nx = b.st[1];
        if (nloc == 0u) { xcd_barrier_complete(bar, b.x, nloc, nx); b.st[0] = nloc; b.st[1] = nx; }
        const unsigned old = xb_add(&bar[XB_XSUB(b.x)], 1u);
        const unsigned gen = old / nloc;
        if (old + 1u == (gen + 1u) * nloc) {
            __builtin_amdgcn_fence(__ATOMIC_RELEASE, "agent");
            asm volatile("s_waitcnt vmcnt(0)" ::: "memory");
            const unsigned og = xb_add(&bar[XB_TOP], 1u);
            const unsigned tg = og / nx;
            if (og + 1u == (tg + 1u) * nx) xb_add(&bar[XB_TOPGEN], 1u);
            else XB_SPIN(xb_ld(&bar[XB_TOPGEN]) == tg, bar);
            __builtin_amdgcn_fence(__ATOMIC_ACQUIRE, "agent");
            xb_add(&bar[XB_XGEN(b.x)], 1u);
            asm volatile("s_waitcnt vmcnt(0)" ::: "memory");
        } else {
            XB_SPIN(xb_ld(&bar[XB_XGEN(b.x)]) == gen, bar);
            __builtin_amdgcn_fence(__ATOMIC_ACQUIRE, "agent");
            asm volatile("s_waitcnt vmcnt(0)" ::: "memory");
        }
    }
    __syncthreads();
}

constexpr int RING_BYTES = 131072, LDSCTL_OFF = RING_BYTES, MISC_OFF = LDSCTL_OFF + 320, LDS_BYTES = 147456;
constexpr int NPH = 16;
struct Args { const float* in[31]; float* out; unsigned char* ws; int ph_lo, ph_hi; };

template <class F>
__device__ __forceinline__ void transpose_item(const F& f, bf16_t* WT, int K, int item, int nblk, LAS float* scr, int lane) {
    const int kb = item / nblk, nb = item % nblk, k0 = 64 * kb, n0 = 32 * nb;
#pragma unroll 8
    for (int i = 0; i < 32; ++i) { const int kk = 2 * i + (lane >> 5); scr[kk * 33 + (lane & 31)] = f.val(k0 + kk, n0 + (lane & 31)); }
    LDS_WAIT(); asm volatile("" ::: "memory");
    const int c = lane & 7;
#pragma unroll
    for (int j = 0; j < 4; ++j) { const int n = (lane >> 3) + 8 * j; const LAS float* s = scr + (8 * c) * 33 + n;
        u32x4 o; o.x = pk2(s[0 * 33], s[1 * 33]); o.y = pk2(s[2 * 33], s[3 * 33]); o.z = pk2(s[4 * 33], s[5 * 33]); o.w = pk2(s[6 * 33], s[7 * 33]);
        *(u32x4*)(WT + (size_t)(n0 + n) * K + k0 + 8 * c) = o; }
    LDS_WAIT(); asm volatile("" ::: "memory");
}
template <class F>
__device__ __forceinline__ void transpose_all(const F& f, bf16_t* WT, int K, int Npad, LAS float* scr, int lane, int gw, int ngw) {
    const int nblk = Npad / 32, nitems = (K / 64) * nblk;
    for (int it = gw; it < nitems; it += ngw) transpose_item(f, WT, K, it, nblk, scr, lane);
}
struct FIn0 { const float* w; const float* g; __device__ __forceinline__ float val(int k, int n) const { return w[(size_t)k * EVEN_IN + n] * g[k]; } };
struct FDt0 { const float* w; const float* g; __device__ __forceinline__ float val(int k, int n) const { return n < 16 ? w[(size_t)k * EVEN_IN + 3072 + n] * g[k] : 0.f; } };
struct FPlain { const float* w; int N; __device__ __forceinline__ float val(int k, int n) const { return w[(size_t)k * N + n]; } };
struct FOut0 { const float* w; const float* g; __device__ __forceinline__ float val(int k, int n) const { return k < 1024 ? w[(size_t)(512 + k) * 1024 + n] * g[k] : w[(size_t)(k - 1024) * 1024 + n]; } };
struct FGu { const float* wg; const float* wu; const float* g; __device__ __forceinline__ float val(int k, int n) const {
    const int tile = n >> 8, q = n & 255, j = tile * 128 + (q >> 3) * 4 + (q & 3); const long dlt = (q & 4) ? (long)(wu - wg) : 0L; return wg[dlt + (long)k * FFH + j] * g[k]; } };
struct FIn1 { const float* w; const float* g; __device__ __forceinline__ float val(int k, int n) const {
    int col; float sc = 1.f;
    if (n < 1024) { const int head = (n & 511) >> 7, pc = n & 127, i = pc >> 1, d = (pc & 1) ? i + 64 : i; col = (n < 512 ? 0 : 512) + head * 128 + d; if (n >= 512) sc = 0.08838834764831845f; }
    else if (n < 1536) { col = 3072 + (n - 1024); sc = 0.08838834764831845f; }
    else if (n < 2048) col = 3584 + (n - 1536);
    else if (n < 3072) col = 1024 + (n - 2048);
    else col = 4096 + (n - 3072);
    return w[(size_t)k * ODD_IN + col] * g[k] * sc; } };
struct FAlr { const float* w; const float* g; __device__ __forceinline__ float val(int k, int n) const { return n < 16 ? w[(size_t)k * ODD_IN + 5120 + n] * g[k] : 0.f; } };
struct FGate { const float* w; const float* g; __device__ __forceinline__ float val(int k, int n) const { const int col = n < 1024 ? 2048 + n : 5136 + (n - 1024); return w[(size_t)k * ODD_IN + col] * g[k]; } };
struct FOut1 { const float* w; const float* gr; const float* gg; __device__ __forceinline__ float val(int k, int n) const { return w[(size_t)k * 1024 + n] * (k < 1024 ? gr[k] : gg[k - 1024]); } };

__device__ __forceinline__ void s5_tables(const Args& A, unsigned char* ws, LAS unsigned char* lds, int g, int tid) {
    LAS f32x2* apow = (LAS f32x2*)lds;
    LAS f32x2* Cc = apow + 65 * 64;
    LAS f32x2* Bb = Cc + 1024;
    LAS float* Kt = (LAS float*)(Bb + 1024);
    const float* lam_re = A.in[5] + g * 64; const float* lam_im = A.in[6] + g * 64;
    const float step = expf(A.in[7][g]);
    const float* b_re = A.in[8] + (size_t)g * 1024; const float* b_im = A.in[9] + (size_t)g * 1024;
    const float* c_re = A.in[10] + (size_t)g * 1024; const float* c_im = A.in[11] + (size_t)g * 1024;
    const float* dsk = A.in[12] + g * 16;
    for (int idx = tid; idx < 65 * 64; idx += NTHREADS) { const int lag = idx >> 6, p = idx & 63; const float lr = lam_re[p], li = lam_im[p];
        const float mag = expf((float)lag * (lr * step)), ang = (float)lag * (li * step); float sn, cs; sincosf(ang, &sn, &cs); apow[idx] = (f32x2){mag * cs, mag * sn}; }
    for (int idx = tid; idx < 1024; idx += NTHREADS) { Cc[idx] = (f32x2){c_re[idx], c_im[idx]};
        const int p = idx >> 4; const float lr = lam_re[p], li = lam_im[p]; const float mag = expf(lr * step); float sn, cs; sincosf(li * step, &sn, &cs);
        const float ar = mag * cs, ai = mag * sn, den = lr * lr + li * li, kr = ((ar - 1.f) * lr + ai * li) / den, ki = (ai * lr - (ar - 1.f) * li) / den;
        const float br = b_re[idx], bi = b_im[idx]; Bb[idx] = (f32x2){kr * br - ki * bi, kr * bi + ki * br}; }
    __syncthreads();
    for (int idx = tid; idx < 16384; idx += NTHREADS) { const int lag = idx >> 8, n = (idx >> 4) & 15, m = idx & 15; float s = 0.f;
        for (int p = 0; p < 64; ++p) { const f32x2 c = Cc[n * 64 + p], a = apow[lag * 64 + p], b = Bb[p * 16 + m];
            const float tr = c.x * a.x - c.y * a.y, ti = c.x * a.y + c.y * a.x; s += tr * b.x - ti * b.y; }
        if (lag == 0 && n == m) s += dsk[n];
        Kt[idx] = s; }
    __syncthreads();
    unsigned* bc = (unsigned*)(ws + WS_S5BC) + (size_t)g * 256 * 768;
    for (int idx = tid; idx < 256 * 768; idx += NTHREADS) { const int r = idx / 768, c2 = (idx % 768) * 2, tp = r >> 4, n = r & 15; float v[2];
#pragma unroll
        for (int e = 0; e < 2; ++e) { const int c = c2 + e;
            if (c < 1024) { const int d = 3 - (c >> 8), kk = c & 255, sp = kk >> 4, m = kk & 15, lag = 16 * d + tp - sp; v[e] = lag >= 0 ? Kt[(lag * 16 + n) * 16 + m] : 0.f; }
            else { const int i = (c - 1024) >> 7, pp = (c - 1024) & 127, p = pp & 63, t = 16 * i + tp; const f32x2 cc = Cc[n * 64 + p], a = apow[(t + 1) * 64 + p];
                v[e] = pp < 64 ? (cc.x * a.x - cc.y * a.y) : -(cc.x * a.y + cc.y * a.x); } }
        bc[idx] = pk2(v[0], v[1]); }
    unsigned* w1 = (unsigned*)(ws + WS_S5W1) + (size_t)g * 128 * 512;
    for (int idx = tid; idx < 128 * 512; idx += NTHREADS) { const int pp = idx >> 9, c2 = (idx & 511) * 2, p = pp & 63; float v[2];
#pragma unroll
        for (int e = 0; e < 2; ++e) { const int c = c2 + e, s = c >> 4, m = c & 15; const f32x2 a = apow[(63 - s) * 64 + p], b = Bb[p * 16 + m];
            v[e] = pp < 64 ? (a.x * b.x - a.y * b.y) : (a.x * b.y + a.y * b.x); }
        w1[idx] = pk2(v[0], v[1]); }
    if (tid < 64) *(f32x2*)((float*)(ws + WS_A64) + (size_t)(g * 64 + tid) * 2) = apow[64 * 64 + tid];
    __syncthreads();
}

__device__ __forceinline__ void skinny16(const bf16_t* hb, const bf16_t* wt, const float* ssq, float* out, int gw, int ngw, int lane) {
    for (int task = gw; task < T / 16; task += ngw) {
        const int r0 = task * 16; f32x4 acc = (f32x4){0.f, 0.f, 0.f, 0.f};
        const bf16_t* ap = hb + (size_t)(r0 + (lane & 15)) * 1024 + (lane >> 4) * 8; const bf16_t* bp = wt + (size_t)(lane & 15) * 1024 + (lane >> 4) * 8;
#pragma unroll 4
        for (int kk = 0; kk < 32; ++kk) { const bf16x8 a = *(const bf16x8*)(ap + kk * 32), b = *(const bf16x8*)(bp + kk * 32); acc = __builtin_amdgcn_mfma_f32_16x16x32_bf16(a, b, acc, 0, 0, 0); }
#pragma unroll
        for (int j = 0; j < 4; ++j) { const int row = r0 + (lane >> 4) * 4 + j; out[(size_t)row * 16 + (lane & 15)] = acc[j] * row_rstd(ssq, row); }
    }
}

template <int STRIDE>
__device__ __forceinline__ bf16x8 ldfrag(const LAS unsigned char* base, int row0, int k0, int lane) {
    return *(const LAS bf16x8*)(base + (row0 + (lane & 15)) * STRIDE + (k0 + (lane >> 4) * 8) * 2);
}
#define MFMA16(a, b, c) __builtin_amdgcn_mfma_f32_16x16x32_bf16(a, b, c, 0, 0, 0)
__device__ __forceinline__ u32x2 pack4(const f32x4 v) { u32x2 w; w.x = cvt_pk_bf16(v[0], v[1]); w.y = cvt_pk_bf16(v[2], v[3]); return w; }
__device__ __forceinline__ u32x4 pack8f(const float (&v)[8]) { u32x4 w; w.x = cvt_pk_bf16(v[0], v[1]); w.y = cvt_pk_bf16(v[2], v[3]); w.z = cvt_pk_bf16(v[4], v[5]); w.w = cvt_pk_bf16(v[6], v[7]); return w; }

constexpr int M1_QP = 0, M1_KN = 17408, M1_KDT = 34816, M1_VT = 53248, M1_P = 62464, M1_ST = 71680, M1_XCH = 106496, M1_EDEC = 110592;
__device__ __forceinline__ void mix1_item(LAS unsigned char* lds, unsigned char* ws, int item, int wave, int lane) {
    const int mixer = item >> 7, b = (item >> 4) & 7, h = (item >> 2) & 3, vq = item & 3;
    const bf16_t* qkv = (const bf16_t*)(ws + WS_QKV); const bf16_t* loga = (const bf16_t*)(ws + WS_LOGA);
    bf16_t* out = (bf16_t*)(ws + WS_QKV);
    const int qoff = (mixer ? 1024 : 0) + h * 128 + 2 * lane, koff = qoff + 512, vcol = 2048 + (mixer ? 1024 : 0) + h * 256 + vq * 64;
    const float lgam = logf(1.0f - exp2f(-5.0f - (float)h));
    const int mt = wave >> 1, nt0 = (wave & 1) * 2, dt0 = (wave & 1) * 4;
    f32x4 accs[4], o0 = (f32x4){0.f, 0.f, 0.f, 0.f}, o1 = o0;
#pragma unroll
    for (int i = 0; i < 4; ++i) accs[i] = (f32x4){0.f, 0.f, 0.f, 0.f};
    unsigned qr[8], kr[8], lr[8], vr[8];
#define M1_LOAD(c) do { _Pragma("unroll") for (int t = 0; t < 8; ++t) { const size_t row = (size_t)b * SEQ + (c) * 64 + 8 * wave + t; const bf16_t* rp = qkv + row * 4096; \
        qr[t] = *(const unsigned*)(rp + qoff); kr[t] = *(const unsigned*)(rp + koff); vr[t] = rp[vcol + lane]; \
        lr[t] = mixer ? *(const unsigned*)(loga + row * 512 + h * 128 + 2 * lane) : 0u; } } while (0)
    M1_LOAD(0);
    for (int c = 0; c < 32; ++c) {
        const int cur = c & 1, nxt = cur ^ 1;
        float c0[8], c1[8], run0 = 0.f, run1 = 0.f;
#pragma unroll
        for (int t = 0; t < 8; ++t) { const float la0 = mixer ? bflo(lr[t]) : lgam, la1 = mixer ? bfhi(lr[t]) : lgam; run0 += la0; run1 += la1; c0[t] = run0; c1[t] = run1; }
        *(LAS f32x2*)(lds + M1_XCH + (wave * 128 + 2 * lane) * 4) = (f32x2){run0, run1};
        __syncthreads();
        float pre0 = 0.f, pre1 = 0.f, tot0 = 0.f, tot1 = 0.f;
#pragma unroll
        for (int w2 = 0; w2 < 8; ++w2) { const f32x2 x = *(const LAS f32x2*)(lds + M1_XCH + (w2 * 128 + 2 * lane) * 4); tot0 += x.x; tot1 += x.y; if (w2 < wave) { pre0 += x.x; pre1 += x.y; } }
        float kd0[8], kd1[8];
#pragma unroll
        for (int t = 0; t < 8; ++t) {
            const float b0 = pre0 + c0[t], b1 = pre1 + c1[t];
            const float ep0 = __expf(b0), ep1 = __expf(b1), en0 = __expf(-b0), en1 = __expf(-b1), ed0 = __expf(tot0 - b0), ed1 = __expf(tot1 - b1);
            const float q0 = bflo(qr[t]), q1 = bfhi(qr[t]), k0 = bflo(kr[t]), k1 = bfhi(kr[t]);
            *(LAS unsigned*)(lds + M1_QP + (8 * wave + t) * 272 + 4 * lane) = cvt_pk_bf16(q0 * ep0, q1 * ep1);
            *(LAS unsigned*)(lds + M1_KN + (8 * wave + t) * 272 + 4 * lane) = cvt_pk_bf16(k0 * en0, k1 * en1);
            kd0[t] = k0 * ed0; kd1[t] = k1 * ed1;
        }
        *(LAS u32x4*)(lds + M1_KDT + (2 * lane) * 144 + 16 * wave) = pack8f(kd0);
        *(LAS u32x4*)(lds + M1_KDT + (2 * lane + 1) * 144 + 16 * wave) = pack8f(kd1);
        if (wave == 0) *(LAS f32x2*)(lds + M1_EDEC + 8 * lane) = (f32x2){__expf(tot0), __expf(tot1)};
        { u32x4 vv; vv.x = vr[0] | (vr[1] << 16); vv.y = vr[2] | (vr[3] << 16); vv.z = vr[4] | (vr[5] << 16); vv.w = vr[6] | (vr[7] << 16); *(LAS u32x4*)(lds + M1_VT + lane * 144 + 16 * wave) = vv; }
        if (c + 1 < 32) M1_LOAD(c + 1);
        __syncthreads();
        bf16x8 qa[4];
#pragma unroll
        for (int ks = 0; ks < 4; ++ks) qa[ks] = ldfrag<272>(lds + M1_QP, 16 * mt, 32 * ks, lane);
        f32x4 p0 = (f32x4){0.f, 0.f, 0.f, 0.f}, p1 = p0;
#pragma unroll
        for (int ks = 0; ks < 4; ++ks) { const bf16x8 k0f = ldfrag<272>(lds + M1_KN, 16 * nt0, 32 * ks, lane), k1f = ldfrag<272>(lds + M1_KN, 16 * (nt0 + 1), 32 * ks, lane);
            p0 = MFMA16(k0f, qa[ks], p0); p1 = MFMA16(k1f, qa[ks], p1); }
        const int ii = 16 * mt + (lane & 15);
        { const int j0 = 16 * nt0 + 4 * (lane >> 4), j1 = j0 + 16;
#pragma unroll
          for (int r = 0; r < 4; ++r) { if (j0 + r > ii) p0[r] = 0.f; if (j1 + r > ii) p1[r] = 0.f; }
          *(LAS u32x2*)(lds + M1_P + ii * 144 + j0 * 2) = pack4(p0); *(LAS u32x2*)(lds + M1_P + ii * 144 + j1 * 2) = pack4(p1); }
        if (c > 0) {
#pragma unroll
            for (int ks = 0; ks < 4; ++ks) { const bf16x8 s0 = ldfrag<272>(lds + M1_ST + cur * 17408, 16 * nt0, 32 * ks, lane), s1 = ldfrag<272>(lds + M1_ST + cur * 17408, 16 * (nt0 + 1), 32 * ks, lane);
                o0 = MFMA16(s0, qa[ks], o0); o1 = MFMA16(s1, qa[ks], o1); }
        }
#pragma unroll
        for (int dtl = 0; dtl < 4; ++dtl) { const f32x4 e = *(const LAS f32x4*)(lds + M1_EDEC + (16 * (dt0 + dtl) + 4 * (lane >> 4)) * 4); accs[dtl] = accs[dtl] * e; }
#pragma unroll
        for (int ks = 0; ks < 2; ++ks) { const bf16x8 va = ldfrag<144>(lds + M1_VT, 16 * mt, 32 * ks, lane);
#pragma unroll
            for (int dtl = 0; dtl < 4; ++dtl) { const bf16x8 kb = ldfrag<144>(lds + M1_KDT, 16 * (dt0 + dtl), 32 * ks, lane); accs[dtl] = MFMA16(kb, va, accs[dtl]); } }
#pragma unroll
        for (int dtl = 0; dtl < 4; ++dtl) *(LAS u32x2*)(lds + M1_ST + nxt * 17408 + ii * 272 + (16 * (dt0 + dtl) + 4 * (lane >> 4)) * 2) = pack4(accs[dtl]);
        __syncthreads();
#pragma unroll
        for (int ks = 0; ks < 2; ++ks) { const bf16x8 pa = ldfrag<144>(lds + M1_P, 16 * mt, 32 * ks, lane), v0 = ldfrag<144>(lds + M1_VT, 16 * nt0, 32 * ks, lane), v1 = ldfrag<144>(lds + M1_VT, 16 * (nt0 + 1), 32 * ks, lane);
            o0 = MFMA16(v0, pa, o0); o1 = MFMA16(v1, pa, o1); }
        { bf16_t* op = out + ((size_t)b * SEQ + c * 64 + ii) * 4096 + vcol + 16 * nt0 + 4 * (lane >> 4);
          *(u32x2*)op = pack4(o0); *(u32x2*)(op + 16) = pack4(o1); }
        o0 = (f32x4){0.f, 0.f, 0.f, 0.f}; o1 = o0;
    }
    __syncthreads();
#undef M1_LOAD
}

constexpr int S_CA = 0, S_CP = 9216, S_BN = 18432, S_BDT = 27648, S_XT = 36864, S_XS = 46080, S_P = 55296, S_ST = 64512;
__device__ __forceinline__ void ssd_item(LAS unsigned char* lds, unsigned char* ws, const float* cw, const float* cb, float dt_bias, float aneg, float dsk, int item, int wave, int lane) {
    const int b = item >> 4, h = item & 15, g = h >> 2;
    const bf16_t* xbc = (const bf16_t*)(ws + WS_XBC); const bf16_t* zs = (const bf16_t*)(ws + WS_ZS); const float* dtb = (const float*)(ws + WS_DT);
    bf16_t* yab = (bf16_t*)(ws + WS_YAB); float* ssqb = (float*)(ws + WS_SSQB);
    const int cx = h * 64 + lane, cB = 1024 + g * 64 + lane, cC = 1280 + g * 64 + lane;
    float wx[4], wb[4], wc_[4];
#pragma unroll
    for (int k = 0; k < 4; ++k) { wx[k] = cw[k * 1536 + cx]; wb[k] = cw[k * 1536 + cB]; wc_[k] = cw[k * 1536 + cC]; }
    const float bx_ = cb[cx], bb_ = cb[cB], bc_ = cb[cC];
    const int mt = wave >> 1, nt0 = (wave & 1) * 2;
    f32x4 accs0 = (f32x4){0.f, 0.f, 0.f, 0.f}, accs1 = accs0, o0 = accs0, o1 = accs0;
    unsigned xr[11], br[11], cr[11]; float dtr;
#define SSD_LOAD(c) do { _Pragma("unroll") for (int rr = 0; rr < 11; ++rr) { const int trow = (c) * 64 + 8 * wave - 3 + rr; \
        if (trow >= 0) { const bf16_t* rp = xbc + ((size_t)b * SEQ + trow) * 1536; xr[rr] = rp[cx]; br[rr] = rp[cB]; cr[rr] = rp[cC]; } else { xr[rr] = 0u; br[rr] = 0u; cr[rr] = 0u; } } \
        dtr = dtb[((size_t)b * SEQ + (c) * 64 + lane) * 16 + h]; } while (0)
    SSD_LOAD(0);
    for (int c = 0; c < 32; ++c) {
        const int cur = c & 1, nxt = cur ^ 1;
        const size_t row0 = (size_t)b * SEQ + c * 64;
        const int ii = 16 * mt + (lane & 15);
        const u32x2 z0 = *(const u32x2*)(zs + (row0 + ii) * 1024 + h * 64 + 16 * nt0 + 4 * (lane >> 4)), z1 = *(const u32x2*)(zs + (row0 + ii) * 1024 + h * 64 + 16 * nt0 + 16 + 4 * (lane >> 4));
        const float dr = dtr + dt_bias, dt = dr > 20.f ? dr : log1pf(__expf(dr));
        float acum = aneg * dt;
#pragma unroll
        for (int o = 1; o < 64; o <<= 1) { const float v = __shfl_up(acum, o); if (lane >= o) acum += v; }
        const float a63 = __int_as_float(__builtin_amdgcn_readlane(__float_as_int(acum), 63));
        float xd[8], bd[8];
#pragma unroll
        for (int t = 0; t < 8; ++t) {
            const int tok = 8 * wave + t;
            const float dt_t = __int_as_float(__builtin_amdgcn_readlane(__float_as_int(dt), tok)), ac_t = __int_as_float(__builtin_amdgcn_readlane(__float_as_int(acum), tok));
            float xv = bx_, bv = bb_, cv = bc_;
#pragma unroll
            for (int k = 0; k < 4; ++k) { xv += wx[k] * bf2f(xr[t + k]); bv += wb[k] * bf2f(br[t + k]); cv += wc_[k] * bf2f(cr[t + k]); }
            xv = siluf_(xv); bv = siluf_(bv); cv = siluf_(cv);
            xd[t] = xv * dt_t; bd[t] = bv * __expf(a63 - ac_t);
            *(LAS bf16_t*)(lds + S_XS + tok * 144 + 2 * lane) = (bf16_t)f2bf(xv);
            *(LAS bf16_t*)(lds + S_BN + tok * 144 + 2 * lane) = (bf16_t)f2bf(bv);
            *(LAS bf16_t*)(lds + S_CA + tok * 144 + 2 * lane) = (bf16_t)f2bf(cv);
            *(LAS bf16_t*)(lds + S_CP + tok * 144 + 2 * lane) = (bf16_t)f2bf(cv * __expf(ac_t));
        }
        *(LAS u32x4*)(lds + S_XT + lane * 144 + 16 * wave) = pack8f(xd);
        *(LAS u32x4*)(lds + S_BDT + lane * 144 + 16 * wave) = pack8f(bd);
        if (c + 1 < 32) SSD_LOAD(c + 1);
        __syncthreads();
        bf16x8 ca[2];
#pragma unroll
        for (int ks = 0; ks < 2; ++ks) ca[ks] = ldfrag<144>(lds + S_CA, 16 * mt, 32 * ks, lane);
        f32x4 p0 = (f32x4){0.f, 0.f, 0.f, 0.f}, p1 = p0;
#pragma unroll
        for (int ks = 0; ks < 2; ++ks) { const bf16x8 b0f = ldfrag<144>(lds + S_BN, 16 * nt0, 32 * ks, lane), b1f = ldfrag<144>(lds + S_BN, 16 * (nt0 + 1), 32 * ks, lane);
            p0 = MFMA16(b0f, ca[ks], p0); p1 = MFMA16(b1f, ca[ks], p1); }
        { const float al = __shfl(acum, ii); const int j0 = 16 * nt0 + 4 * (lane >> 4), j1 = j0 + 16;
#pragma unroll
          for (int r = 0; r < 4; ++r) { const float as0 = __shfl(acum, j0 + r), as1 = __shfl(acum, j1 + r);
              p0[r] = (j0 + r <= ii) ? p0[r] * __expf(al - as0) : 0.f; p1[r] = (j1 + r <= ii) ? p1[r] * __expf(al - as1) : 0.f; }
          *(LAS u32x2*)(lds + S_P + ii * 144 + j0 * 2) = pack4(p0); *(LAS u32x2*)(lds + S_P + ii * 144 + j1 * 2) = pack4(p1); }
        if (c > 0) {
#pragma unroll
            for (int ks = 0; ks < 2; ++ks) { const bf16x8 cp = ldfrag<144>(lds + S_CP, 16 * mt, 32 * ks, lane), s0 = ldfrag<144>(lds + S_ST + cur * 9216, 16 * nt0, 32 * ks, lane), s1 = ldfrag<144>(lds + S_ST + cur * 9216, 16 * (nt0 + 1), 32 * ks, lane);
                o0 = MFMA16(s0, cp, o0); o1 = MFMA16(s1, cp, o1); }
        }
        { const float e63 = __expf(a63); accs0 = accs0 * e63; accs1 = accs1 * e63; }
#pragma unroll
        for (int ks = 0; ks < 2; ++ks) { const bf16x8 xa = ldfrag<144>(lds + S_XT, 16 * mt, 32 * ks, lane), n0 = ldfrag<144>(lds + S_BDT, 16 * nt0, 32 * ks, lane), n1 = ldfrag<144>(lds + S_BDT, 16 * (nt0 + 1), 32 * ks, lane);
            accs0 = MFMA16(n0, xa, accs0); accs1 = MFMA16(n1, xa, accs1); }
        *(LAS u32x2*)(lds + S_ST + nxt * 9216 + ii * 144 + (16 * nt0 + 4 * (lane >> 4)) * 2) = pack4(accs0);
        *(LAS u32x2*)(lds + S_ST + nxt * 9216 + ii * 144 + (16 * nt0 + 16 + 4 * (lane >> 4)) * 2) = pack4(accs1);
        __syncthreads();
#pragma unroll
        for (int ks = 0; ks < 2; ++ks) { const bf16x8 pa = ldfrag<144>(lds + S_P, 16 * mt, 32 * ks, lane), x0 = ldfrag<144>(lds + S_XT, 16 * nt0, 32 * ks, lane), x1 = ldfrag<144>(lds + S_XT, 16 * (nt0 + 1), 32 * ks, lane);
            o0 = MFMA16(x0, pa, o0); o1 = MFMA16(x1, pa, o1); }
        { const int pc0 = 16 * nt0 + 4 * (lane >> 4);
          const u32x2 xs0 = *(const LAS u32x2*)(lds + S_XS + ii * 144 + pc0 * 2), xs1 = *(const LAS u32x2*)(lds + S_XS + ii * 144 + (pc0 + 16) * 2);
          f32x4 y0, y1;
          y0[0] = (o0[0] + dsk * bflo(xs0.x)) * siluf_(bflo(z0.x)); y0[1] = (o0[1] + dsk * bfhi(xs0.x)) * siluf_(bfhi(z0.x)); y0[2] = (o0[2] + dsk * bflo(xs0.y)) * siluf_(bflo(z0.y)); y0[3] = (o0[3] + dsk * bfhi(xs0.y)) * siluf_(bfhi(z0.y));
          y1[0] = (o1[0] + dsk * bflo(xs1.x)) * siluf_(bflo(z1.x)); y1[1] = (o1[1] + dsk * bfhi(xs1.x)) * siluf_(bfhi(z1.x)); y1[2] = (o1[2] + dsk * bflo(xs1.y)) * siluf_(bflo(z1.y)); y1[3] = (o1[3] + dsk * bfhi(xs1.y)) * siluf_(bfhi(z1.y));
          float ss = ((y0[0] * y0[0] + y0[1] * y0[1]) + (y0[2] * y0[2] + y0[3] * y0[3])) + ((y1[0] * y1[0] + y1[1] * y1[1]) + (y1[2] * y1[2] + y1[3] * y1[3]));
          ss += __shfl_xor(ss, 16); ss += __shfl_xor(ss, 32);
          bf16_t* op = yab + (row0 + ii) * 1536 + h * 64 + pc0;
          *(u32x2*)op = pack4(y0); *(u32x2*)(op + 16) = pack4(y1);
          if (lane < 16) ssqb[(row0 + ii) * 32 + h * 2 + (wave & 1)] = ss; }
        o0 = (f32x4){0.f, 0.f, 0.f, 0.f}; o1 = o0;
        __syncthreads();
    }
#undef SSD_LOAD
}

__device__ __forceinline__ void skinny_loga(const bf16_t* hb, const bf16_t* wt, const float* ssq, const float* gwt, const float* gbs, bf16_t* loga, int gw, int ngw, int lane) {
    for (int task = gw; task < T / 16; task += ngw) {
        const int r0 = task * 16; f32x4 acc = (f32x4){0.f, 0.f, 0.f, 0.f};
        const bf16_t* ap = hb + (size_t)(r0 + (lane & 15)) * 1024 + (lane >> 4) * 8; const bf16_t* bp = wt + (size_t)(lane & 15) * 1024 + (lane >> 4) * 8;
#pragma unroll 4
        for (int kk = 0; kk < 32; ++kk) { const bf16x8 a = *(const bf16x8*)(ap + kk * 32), b = *(const bf16x8*)(bp + kk * 32); acc = MFMA16(a, b, acc); }
#pragma unroll
        for (int j = 0; j < 4; ++j) acc[j] *= row_rstd(ssq, r0 + (lane >> 4) * 4 + j);
#pragma unroll
        for (int half = 0; half < 2; ++half) {
            float z[8][8];
#pragma unroll
            for (int m = 0; m < 8; ++m) { const float bsv = gbs[lane + 64 * m];
#pragma unroll
                for (int rr = 0; rr < 8; ++rr) z[rr][m] = bsv; }
            for (int r = 0; r < 16; ++r) {
                float gv[8];
#pragma unroll
                for (int m = 0; m < 8; ++m) gv[m] = gwt[r * 512 + lane + 64 * m];
#pragma unroll
                for (int rr = 0; rr < 8; ++rr) { const int rl = 8 * half + rr; const float sv = __int_as_float(__builtin_amdgcn_readlane(__float_as_int(acc[rl & 3]), r + 16 * (rl >> 2)));
#pragma unroll
                    for (int m = 0; m < 8; ++m) z[rr][m] += sv * gv[m]; }
            }
#pragma unroll
            for (int rr = 0; rr < 8; ++rr)
#pragma unroll
                for (int m = 0; m < 8; ++m) { const float zz = z[rr][m], la = (fminf(zz, 0.f) - __logf(1.0f + __expf(-fabsf(zz)))) * 0.0625f;
                    loga[(size_t)(r0 + 8 * half + rr) * 512 + lane + 64 * m] = (bf16_t)f2bf(la); }
        }
    }
}

__global__ void __launch_bounds__(NTHREADS, 2) mega_fwd(Args args) {
    extern __shared__ __attribute__((aligned(16))) unsigned char lds_raw[];
    LAS unsigned char* lds = (LAS unsigned char*)lds_raw;
    volatile LAS unsigned* MISC = (volatile LAS unsigned*)(lds + MISC_OFF);
    const int tid = threadIdx.x, lane = tid & 63, wave = __builtin_amdgcn_readfirstlane(tid >> 6);
    const int G = gridDim.x, bx = blockIdx.x;
    const int vcu = (G % 8 == 0) ? (bx % 8) * (G / 8) + bx / 8 : bx;
    const int gw = vcu * NWAVES + wave, NGW = G * NWAVES;
    const int gtid = gw * 64 + lane, NGT = NGW * 64;
    unsigned char* ws = args.ws;
    for (int u = tid; u < (LDS_BYTES - LDSCTL_OFF) / 4; u += NTHREADS) ((LAS unsigned*)(lds + LDSCTL_OFF))[u] = 0u;
    __syncthreads();
    XcdBarrier bar; bar.bar = (unsigned*)(ws + WS_CTL) + CW_BAR; bar.x = 0; bar.st = nullptr;
    if (!MK_PER_PHASE) bar = xcd_barrier_post((unsigned*)(ws + WS_CTL) + CW_BAR, MISC + 8);
    const int lo = args.ph_lo, hi = args.ph_hi;
#define IN(k) (lo <= (k) && (k) < hi)
#define SEAM(k) do { if (IN(k) && IN((k) + 1)) xcd_barrier(bar); } while (0)

    float* hres = args.out;
    float* ssq = (float*)(ws + WS_SSQ);
    bf16_t* hb = (bf16_t*)(ws + WS_HB);

    if (IN(0)) {
        LAS float* scr = (LAS float*)(lds + wave * 16384);
        if (bx < 32) s5_tables(args, ws, lds, bx, tid);
        { FIn0 f{args.in[4], args.in[1]}; transpose_all(f, (bf16_t*)(ws + WS_W0IN), 1024, 3072, scr, lane, gw, NGW); }
        { FDt0 f{args.in[4], args.in[1]}; transpose_all(f, (bf16_t*)(ws + WS_W0DT), 1024, 32, scr, lane, gw, NGW); }
        { FPlain f{args.in[13], 512}; transpose_all(f, (bf16_t*)(ws + WS_W0GLU), 512, 512, scr, lane, gw, NGW); }
        { FOut0 f{args.in[21], args.in[20]}; transpose_all(f, (bf16_t*)(ws + WS_W0OUT), 1536, 1024, scr, lane, gw, NGW); }
        { FGu f{args.in[28], args.in[29], args.in[2]}; transpose_all(f, (bf16_t*)(ws + WS_W0GU), 1024, 5632, scr, lane, gw, NGW); }
        { FPlain f{args.in[30], 1024}; transpose_all(f, (bf16_t*)(ws + WS_W0DN), FFH, 1024, scr, lane, gw, NGW); }
        float* rot = (float*)(ws + WS_ROT);
        for (int idx = gtid; idx < 2048 * 64; idx += NGT) { const int l = idx >> 6, i = idx & 63; const float invf = powf(10000.0f, -(float)i / 64.0f), ang = (float)l * invf; float sn, cs; sincosf(ang, &sn, &cs);
            *(f32x2*)(rot + (size_t)idx * 2) = (f32x2){cs, sn}; }
        const float* x = args.in[0];
        for (int row = gw; row < T; row += NGW) {
            const f32x4* xr = (const f32x4*)(x + (size_t)row * 1024) + lane; float s = 0.f; f32x4 v[4];
#pragma unroll
            for (int j = 0; j < 4; ++j) { v[j] = xr[64 * j]; s += (v[j][0] * v[j][0] + v[j][1] * v[j][1]) + (v[j][2] * v[j][2] + v[j][3] * v[j][3]); }
            s = wave_sum(s);
            u32x2* o = (u32x2*)(hb + (size_t)row * 1024) + lane;
#pragma unroll
            for (int j = 0; j < 4; ++j) { u32x2 w; w.x = pk2(v[j][0], v[j][1]); w.y = pk2(v[j][2], v[j][3]); o[64 * j] = w; }
            if (lane < 16) ssq[(size_t)row * 16 + lane] = lane == 0 ? s : 0.f;
        }
    }
    SEAM(0);
    if (IN(1)) {
        skinny16(hb, (const bf16_t*)(ws + WS_W0DT), ssq, (float*)(ws + WS_DT), gw, NGW, lane);
        OrdStd S; S.init(hb, ws + WS_W0IN, 1024, 1024, T, 3072, 1024, G, bx);
        const GDesc gd{1024, 1024, 128L * 1024 * 2, 128L * 1024 * 2};
        EpiIn0 E{ssq, (bf16_t*)(ws + WS_UPERM), (bf16_t*)(ws + WS_ZS), (bf16_t*)(ws + WS_XBC)};
        gemm_phase<EpiIn0, OrdStd, true>(lds, gd, S, E);
    }
    SEAM(1);
    if (IN(2)) {
        if (bx < 32) {
            OrdS5A S{(const char*)(ws + WS_UPERM), (const char*)(ws + WS_S5W1), bx};
            const GDesc gd{1152, 1024, 128L * 1152 * 2, 0};
            EpiS5A E{(bf16_t*)(ws + WS_UPERM), (const float*)(ws + WS_A64)};
            gemm_phase<EpiS5A, OrdS5A, false>(lds, gd, S, E);
        } else {
            for (int item = bx - 32; item < 128; item += (G - 32)) {
                const int h = item & 15;
                ssd_item(lds, ws, args.in[15], args.in[16], args.in[17][h], -expf(args.in[18][h]), args.in[19][h], item, wave, lane);
            }
        }
    }
    SEAM(2);
    if (IN(3)) {
        if (bx < 128) {
            OrdS5C S{(const char*)(ws + WS_UPERM), (const char*)(ws + WS_S5BC), bx};
            const GDesc gd{1152, 1536, 128L * 1152 * 2, 128L * 1536 * 2};
            EpiS5C E{(bf16_t*)(ws + WS_ZG)};
            gemm_phase<EpiS5C, OrdS5C, false>(lds, gd, S, E);
        } else {
            bf16_t* yab = (bf16_t*)(ws + WS_YAB); const float* ssqb = (const float*)(ws + WS_SSQB);
            for (int row = (bx - 128) * NWAVES + wave; row < T; row += (G - 128) * NWAVES) {
                const f32x4* sp = (const f32x4*)(ssqb + (size_t)row * 32); float sacc = 0.f;
#pragma unroll
                for (int j = 0; j < 8; ++j) { const f32x4 v = sp[j]; sacc += (v[0] + v[1]) + (v[2] + v[3]); }
                const float rs = rsqrtf(sacc * (1.0f / 1024.0f) + EPS);
                u32x2* p = (u32x2*)(yab + (size_t)row * 1536) + lane;
#pragma unroll
                for (int j = 0; j < 4; ++j) { u32x2 w = p[64 * j]; w.x = pk2(bflo(w.x) * rs, bfhi(w.x) * rs); w.y = pk2(bflo(w.y) * rs, bfhi(w.y) * rs); p[64 * j] = w; }
            }
        }
    }
    SEAM(3);
    if (IN(4)) {
        if (bx < 128) {
            OrdStd S; S.init(ws + WS_ZG, ws + WS_W0GLU, 512, 512, T, 512, 512, 128, bx);
            const GDesc gd{512, 512, 128L * 512 * 2, 128L * 512 * 2};
            EpiGlu E{(const bf16_t*)(ws + WS_ZG), args.in[14], (bf16_t*)(ws + WS_YAB)};
            gemm_phase<EpiGlu, OrdStd, false>(lds, gd, S, E);
        }
    }
    SEAM(4);
    if (IN(5)) {
        OrdStd S; S.init(ws + WS_YAB, ws + WS_W0OUT, 1536, 1536, T, 1024, 1536, G, bx);
        const GDesc gd{1536, 1536, 128L * 1536 * 2, 128L * 1536 * 2};
        EpiRes E{args.in[0], hres, hb, ssq};
        gemm_phase<EpiRes, OrdStd, true>(lds, gd, S, E);
    }
    SEAM(5);
    if (IN(6)) {
        LAS float* scr = (LAS float*)(lds + wave * 16384);
        { FIn1 f{args.in[22], args.in[1] + 1024}; transpose_all(f, (bf16_t*)(ws + WS_W1IN), 1024, 4096, scr, lane, gw, NGW); }
        { FAlr f{args.in[22], args.in[1] + 1024}; transpose_all(f, (bf16_t*)(ws + WS_W1ALR), 1024, 32, scr, lane, gw, NGW); }
        { FGate f{args.in[22], args.in[1] + 1024}; transpose_all(f, (bf16_t*)(ws + WS_W1GT), 1024, 2048, scr, lane, gw, NGW); }
        { FOut1 f{args.in[27], args.in[23], args.in[26]}; transpose_all(f, (bf16_t*)(ws + WS_W1OUT), 2048, 1024, scr, lane, gw, NGW); }
        { FGu f{args.in[28] + (size_t)1024 * FFH, args.in[29] + (size_t)1024 * FFH, args.in[2] + 1024}; transpose_all(f, (bf16_t*)(ws + WS_W1GU), 1024, 5632, scr, lane, gw, NGW); }
        { FPlain f{args.in[30] + (size_t)FFH * 1024, 1024}; transpose_all(f, (bf16_t*)(ws + WS_W1DN), FFH, 1024, scr, lane, gw, NGW); }
        __syncthreads();
        OrdStd S; S.init(hb, ws + WS_W0GU, 1024, 1024, T, 5632, 1024, G, bx);
        const GDesc gd{1024, 1024, 128L * 1024 * 2, 128L * 1024 * 2};
        EpiGu E{ssq, (bf16_t*)(ws + WS_HID0)};
        gemm_phase<EpiGu, OrdStd, true>(lds, gd, S, E);
    }
    SEAM(6);
    if (IN(7)) {
        OrdStd S; S.init(ws + WS_HID0, ws + WS_W0DN, FFH, FFH, T, 1024, FFH, G, bx);
        const GDesc gd{FFH, FFH, 128L * FFH * 2, 128L * FFH * 2};
        EpiRes E{hres, hres, hb, ssq};
        gemm_phase<EpiRes, OrdStd, true>(lds, gd, S, E);
    }
    SEAM(7);
    if (IN(8)) {
        skinny_loga(hb, (const bf16_t*)(ws + WS_W1ALR), ssq, args.in[24], args.in[25], (bf16_t*)(ws + WS_LOGA), gw, NGW, lane);
        OrdStd S; S.init(hb, ws + WS_W1IN, 1024, 1024, T, 4096, 1024, G, bx);
        const GDesc gd{1024, 1024, 128L * 1024 * 2, 128L * 1024 * 2};
        EpiIn1 E{ssq, (const float*)(ws + WS_ROT), (bf16_t*)(ws + WS_QKV)};
        gemm_phase<EpiIn1, OrdStd, true>(lds, gd, S, E);
    }
    SEAM(8);
    if (IN(9)) {
        for (int item = bx; item < 256; item += G) mix1_item(lds, ws, item, wave, lane);
    }
    SEAM(9);
    if (IN(10)) {
        bf16_t* qkv = (bf16_t*)(ws + WS_QKV);
        for (int task = gw; task < T * 8; task += NGW) {
            const int row = task >> 3, hs = task & 7;
            u32x2* p = (u32x2*)(qkv + (size_t)row * 4096 + 2048 + hs * 256) + lane;
            const u32x2 w = *p; const float v0 = bflo(w.x), v1 = bfhi(w.x), v2 = bflo(w.y), v3 = bfhi(w.y);
            const float s1 = wave_sum((v0 + v1) + (v2 + v3)), s2 = wave_sum((v0 * v0 + v1 * v1) + (v2 * v2 + v3 * v3));
            float mu = 0.f, rs;
            if (hs < 4) { mu = s1 * (1.f / 256.f); const float var = fmaxf(s2 * (1.f / 256.f) - mu * mu, 0.f); rs = rsqrtf(var + EPS); }
            else rs = rsqrtf(s2 * (1.f / 256.f) + EPS);
            u32x2 o; o.x = pk2((v0 - mu) * rs, (v1 - mu) * rs); o.y = pk2((v2 - mu) * rs, (v3 - mu) * rs); *p = o;
        }
    }
    SEAM(10);
    if (IN(11)) {
        OrdStd S; S.init(hb, ws + WS_W1GT, 1024, 1024, T, 2048, 1024, G, bx);
        const GDesc gd{1024, 1024, 128L * 1024 * 2, 128L * 1024 * 2};
        EpiGate E{ssq, (bf16_t*)(ws + WS_QKV)};
        gemm_phase<EpiGate, OrdStd, true>(lds, gd, S, E);
    }
    SEAM(11);
    if (IN(12)) {
        OrdStd S; S.init(ws + WS_QKV + 2048 * 2, ws + WS_W1OUT, 4096, 2048, T, 1024, 2048, G, bx);
        const GDesc gd{4096, 2048, 128L * 4096 * 2, 128L * 2048 * 2};
        EpiRes E{hres, hres, hb, ssq};
        gemm_phase<EpiRes, OrdStd, true>(lds, gd, S, E);
    }
    SEAM(12);
    if (IN(13)) {
        OrdStd S; S.init(hb, ws + WS_W1GU, 1024, 1024, T, 5632, 1024, G, bx);
        const GDesc gd{1024, 1024, 128L * 1024 * 2, 128L * 1024 * 2};
        EpiGu E{ssq, (bf16_t*)(ws + WS_HID1)};
        gemm_phase<EpiGu, OrdStd, true>(lds, gd, S, E);
    }
    SEAM(13);
    if (IN(14)) {
        OrdStd S; S.init(ws + WS_HID1, ws + WS_W1DN, FFH, FFH, T, 1024, FFH, G, bx);
        const GDesc gd{FFH, FFH, 128L * FFH * 2, 128L * FFH * 2};
        EpiRes E{hres, hres, hb, ssq};
        gemm_phase<EpiRes, OrdStd, true>(lds, gd, S, E);
    }
    SEAM(14);
    if (IN(15)) {
        const float* fg = args.in[3];
        for (int row = gw; row < T; row += NGW) {
            const float rs = row_rstd(ssq, row);
            f32x4* p = (f32x4*)(hres + (size_t)row * 1024) + lane; const f32x4* gp = (const f32x4*)fg + lane;
#pragma unroll
            for (int j = 0; j < 4; ++j) p[64 * j] = p[64 * j] * rs * gp[64 * j];
        }
    }
#undef IN
#undef SEAM
}

extern "C" void kernel_launch(void* const* d_in, const int* in_sizes, int n_in, void* d_out, int out_size, void* d_ws, size_t ws_size, hipStream_t stream) {
    static int grid = 0;
    if (grid == 0) {
        if (n_in != 31 || out_size != T * DM || ws_size < WS_END) { fprintf(stderr, "kernel_launch: unexpected problem (n_in %d, out %d, ws %zu)\n", n_in, out_size, ws_size); grid = -1; return; }
        int dev = 0, cus = 0, per_cu = 0;
        if (hipGetDevice(&dev) != hipSuccess || hipDeviceGetAttribute(&cus, hipDeviceAttributeMultiprocessorCount, dev) != hipSuccess) { grid = -1; return; }
        if (hipFuncSetAttribute((const void*)mega_fwd, hipFuncAttributeMaxDynamicSharedMemorySize, LDS_BYTES) != hipSuccess) { fprintf(stderr, "kernel_launch: hipFuncSetAttribute failed\n"); grid = -1; return; }
        if (hipOccupancyMaxActiveBlocksPerMultiprocessor(&per_cu, (const void*)mega_fwd, NTHREADS, LDS_BYTES) != hipSuccess || per_cu < 1) { fprintf(stderr, "kernel_launch: occupancy query says %d blocks per CU\n", per_cu); grid = -1; (void)hipGetLastError(); return; }
        grid = cus;
    }
    if (grid < 0) return;
    (void)hipMemsetAsync((char*)d_ws + WS_CTL, 0, CTL_ZERO_BYTES, stream);
    Args a{};
    for (int i = 0; i < 31; ++i) a.in[i] = (const float*)d_in[i];
    a.out = (float*)d_out; a.ws = (unsigned char*)d_ws;
#if MK_PER_PHASE
    for (int p = 0; p < NPH; ++p) { a.ph_lo = p; a.ph_hi = p + 1; hipLaunchKernelGGL(mega_fwd, dim3(grid), dim3(NTHREADS), LDS_BYTES, stream, a); }
#else
    a.ph_lo = 0; a.ph_hi = NPH;
    void* kargs[] = {&a};
    hipError_t e = hipLaunchCooperativeKernel((const void*)mega_fwd, dim3(grid), dim3(NTHREADS), kargs, LDS_BYTES, stream);
    if (e != hipSuccess) fprintf(stderr, "kernel_launch: cooperative launch failed: %s (grid %d)\n", hipGetErrorString(e), grid);
#endif
}
```

```cpp
#include <hip/hip_runtime.h>
#include <cstdio>
#include <cstdint>

#ifndef MK_PER_PHASE
#define MK_PER_PHASE 0
#endif

#define GAS __attribute__((address_space(1)))
#define LAS __attribute__((address_space(3)))
typedef unsigned short bf16_t;
typedef short bf16x8 __attribute__((ext_vector_type(8)));
typedef float f32x4 __attribute__((ext_vector_type(4)));
typedef float f32x2 __attribute__((ext_vector_type(2)));
typedef unsigned u32x4 __attribute__((ext_vector_type(4)));
typedef unsigned u32x2 __attribute__((ext_vector_type(2)));

constexpr int NB = 8, SEQ = 2048, DM = 1024, T = NB * SEQ;
constexpr int EVEN_IN = 3088, ODD_IN = 6160, FFH = 2816;
constexpr float EPS = 1e-6f;
constexpr int NWAVES = 8, NTHREADS = 512;

constexpr size_t MiB = 1u << 20;
constexpr size_t WS_CTL = 0, CTL_ZERO_BYTES = 65536;
constexpr size_t WS_SSQ = 1 * MiB;
constexpr size_t WS_SSQB = 2 * MiB;
constexpr size_t WS_DT = 4 * MiB;
constexpr size_t WS_ROT = 5 * MiB;
constexpr size_t WS_A64 = 6 * MiB;
constexpr size_t WS_HB = 7 * MiB;
constexpr size_t WS_W0IN = 39 * MiB;
constexpr size_t WS_W0DT = 45 * MiB;
constexpr size_t WS_W0GLU = 45 * MiB + 512 * 1024;
constexpr size_t WS_W0OUT = 46 * MiB;
constexpr size_t WS_W0GU = 49 * MiB;
constexpr size_t WS_W0DN = 60 * MiB;
constexpr size_t WS_S5BC = 66 * MiB;
constexpr size_t WS_S5W1 = 90 * MiB;
constexpr size_t WS_UPERM = 98 * MiB;
constexpr size_t WS_ZS = 116 * MiB;
constexpr size_t WS_XBC = 148 * MiB;
constexpr size_t WS_YAB = 196 * MiB;
constexpr size_t WS_S5K = 244 * MiB;
constexpr size_t WS_ZG = WS_HB;
constexpr size_t WS_HID0 = 148 * MiB;
constexpr size_t WS_W1IN = 66 * MiB;
constexpr size_t WS_W1ALR = 74 * MiB;
constexpr size_t WS_W1GT = 74 * MiB + 512 * 1024;
constexpr size_t WS_W1OUT = 79 * MiB;
constexpr size_t WS_W1GU = 83 * MiB;
constexpr size_t WS_W1DN = 94 * MiB;
constexpr size_t WS_QKV = 100 * MiB;
constexpr size_t WS_HID1 = 100 * MiB;
constexpr size_t WS_LOGA = 39 * MiB;
constexpr size_t WS_END = 256 * MiB;

constexpr int CW_BAR = 4096;


typedef __bf16 bf16v2 __attribute__((ext_vector_type(2)));
__device__ __forceinline__ unsigned cvt_pk_bf16(float lo, float hi) { const f32x2 v = {lo, hi}; const bf16v2 r = __builtin_convertvector(v, bf16v2); return __builtin_bit_cast(unsigned, r); }
__device__ __forceinline__ unsigned f2bf(float f) { const __bf16 r = (__bf16)f; return (unsigned)__builtin_bit_cast(unsigned short, r); }
__device__ __forceinline__ unsigned pk2(float lo, float hi) { return cvt_pk_bf16(lo, hi); }
__device__ __forceinline__ float bf2f(unsigned h) { return __uint_as_float(h << 16); }
__device__ __forceinline__ float bflo(unsigned w) { return __uint_as_float(w << 16); }
__device__ __forceinline__ float bfhi(unsigned w) { return __uint_as_float(w & 0xffff0000u); }

__device__ __forceinline__ float wave_sum(float v) {
#pragma unroll
    for (int o = 1; o < 64; o <<= 1) v += __shfl_xor(v, o);
    return v;
}
__device__ __forceinline__ float sigmoidf_(float x) { return __builtin_amdgcn_rcpf(1.0f + __expf(-x)); }
__device__ __forceinline__ float siluf_(float x) { return x * __builtin_amdgcn_rcpf(1.0f + __expf(-x)); }
__device__ __forceinline__ float gelu_tanh(float x) { const float u = 1.5957691216f * (x + 0.044715f * x * x * x); return x * __builtin_amdgcn_rcpf(1.0f + __expf(-u)); }
__device__ __forceinline__ float ld_coh(const float* p) { return __hip_atomic_load(p, __ATOMIC_RELAXED, __HIP_MEMORY_SCOPE_AGENT); }
#define LDS_WAIT() asm volatile("s_waitcnt lgkmcnt(0)" ::: "memory")
#define VM_WAIT() asm volatile("s_waitcnt vmcnt(0)" ::: "memory")

__device__ __forceinline__ float row_rstd(const float* ssq, int row) {
    const f32x4* p = (const f32x4*)(ssq + (size_t)row * 16);
    const f32x4 a = p[0], b = p[1], c = p[2], d = p[3];
    const float s = ((a.x + a.y) + (a.z + a.w)) + ((b.x + b.y) + (b.z + b.w)) + ((c.x + c.y) + (c.z + c.w)) + ((d.x + d.y) + (d.z + d.w));
    return rsqrtf(s * (1.0f / 1024.0f) + EPS);
}

constexpr int BM = 256, BK = 64, HALF = 128, HTB = HALF * BK * 2, STAGE_BYTES = 8 * HTB;
__device__ __forceinline__ int lds_byte(int r, int c) { const int st = (r >> 4) * 2 + (c >> 5), rr = r & 15, cc = c & 31, ob = rr * 64 + cc * 2; return st * 1024 + (ob ^ (((ob >> 9) & 1) << 5)); }
__device__ __forceinline__ void stage_rc(int b, int& R, int& C) { const int st = b / 1024, sb = b % 1024, swz = sb ^ (((sb >> 9) & 1) << 5); R = (st >> 1) * 16 + swz / 64; C = (st & 1) * 32 + (swz % 64) / 2; }
__device__ __forceinline__ int perm32(int rho) { const int n = rho >> 4, i = rho & 15; return 8 * (i >> 2) + 4 * n + (i & 3); }

struct Unit { const char* a; const char* b; long bjump; int pm, pn, nt, aux; };
struct GDesc { int lda, ldb; long hsA, hsB; };

struct OrdStd {
    const char* A; const char* B; int lda, ldb, nM, nN, nwg, G, c, nt;
    __device__ void init(const void* A_, const void* B_, int lda_, int ldb_, int M, int N, int K, int G_, int c_) { A = (const char*)A_; B = (const char*)B_; lda = lda_; ldb = ldb_; nM = M / BM; nN = N / BM; nwg = nM * nN; G = G_; c = c_; nt = K / BK; }
    __device__ bool next(int i, Unit& u) const {
        const long L = (long)i * G + c; if (c < 0 || L >= nwg) return false;
        int wgid = (int)L; { const int q = nwg / 8, r = nwg % 8, xcd = wgid % 8, off = wgid / 8; wgid = (xcd < r ? xcd * (q + 1) : r * (q + 1) + (xcd - r) * q) + off; }
        const int nig = 8 * nN, gid = wgid / nig, fm = gid * 8, gsz = (nM - fm) < 8 ? (nM - fm) : 8;
        u.pm = fm + ((wgid % nig) % gsz); u.pn = (wgid % nig) / gsz; u.nt = nt; u.bjump = 0; u.aux = 0;
        u.a = A + (size_t)u.pm * BM * lda * 2; u.b = B + (size_t)u.pn * BM * ldb * 2; return true;
    }
    __device__ __forceinline__ void a_ready(const Unit&) const {}
    __device__ __forceinline__ void done(const Unit&) const {}
};

template <class Epi, class Sched, bool ALIGN_EPI>
__device__ __forceinline__ void gemm_phase(LAS unsigned char* lds, const GDesc g, const Sched& S, const Epi& E) {
    const int tid = threadIdx.x, wid = __builtin_amdgcn_readfirstlane(tid >> 6), lane = tid & 63, wr = wid >> 2, wc = wid & 3, fr = lane & 15, fq = lane >> 4;
    unsigned voffA[2], voffB[2];
#pragma unroll
    for (int i = 0; i < 2; ++i) { int R, C; stage_rc(tid * 16 + i * 8192, R, C); const int Rb = Epi::PERM ? ((R & ~31) + perm32(R & 31)) : R;
        voffA[i] = (unsigned)(R * g.lda + C) * 2u; voffB[i] = (unsigned)(Rb * g.ldb + C) * 2u; }
    const long kstep = BK * 2;
    const long hsA = g.hsA, hsB = g.hsB;
    const unsigned ldsw = (unsigned)wid * 1024u;
    const int aoff = lds_byte(wr * 64 + fr, fq * 8), boff = lds_byte(wc * 32 + fr, fq * 8);
#define PG8_SA(b, h) (((b) * 2 + (h)) * HTB)
#define PG8_SB(b, h) ((4 + (b) * 2 + (h)) * HTB)
#define PG8_STAGE(bufoff, gbase, voff) do { _Pragma("unroll") for (int _i = 0; _i < 2; ++_i) \
        __builtin_amdgcn_global_load_lds((const unsigned*)((const char*)(gbase) + (voff)[_i]), (LAS unsigned*)(lds + (bufoff) + ldsw + _i * 8192), 16, 0, 0); } while (0)
#define PG8_LDA(dst, b, h) do { _Pragma("unroll") for (int m = 0; m < 4; ++m) _Pragma("unroll") for (int k = 0; k < 2; ++k) dst[m][k] = *(const LAS bf16x8*)(lds + PG8_SA(b, h) + aoff + m * 2048 + k * 1024); } while (0)
#define PG8_LDB(dst, b, h) do { _Pragma("unroll") for (int n = 0; n < 2; ++n) _Pragma("unroll") for (int k = 0; k < 2; ++k) dst[n][k] = *(const LAS bf16x8*)(lds + PG8_SB(b, h) + boff + n * 2048 + k * 1024); } while (0)
#define PG8_MMA(ai, bj, At, Bt) do { __builtin_amdgcn_s_setprio(1); _Pragma("unroll") for (int m = 0; m < 4; ++m) _Pragma("unroll") for (int n = 0; n < 2; ++n) _Pragma("unroll") for (int k = 0; k < 2; ++k) \
        acc[ai][bj][m][n] = __builtin_amdgcn_mfma_f32_16x16x32_bf16(Bt[n][k], At[m][k], acc[ai][bj][m][n], 0, 0, 0); __builtin_amdgcn_s_setprio(0); } while (0)
#define PG8_WAIT_V(n) asm volatile("s_waitcnt vmcnt(" #n ")" ::: "memory")
#define PG8_WAIT_L(n) asm volatile("s_waitcnt lgkmcnt(" #n ")" ::: "memory")
#define PG8_BAR __builtin_amdgcn_s_barrier()
#define PG8_SCHED __builtin_amdgcn_sched_barrier(0)
    Unit cur, nxt; int ui = 0;
    if (!S.next(0, cur)) return;
    f32x4 acc[2][2][4][2];
#pragma unroll
    for (int a = 0; a < 2; ++a)
#pragma unroll
        for (int b = 0; b < 2; ++b)
#pragma unroll
            for (int m = 0; m < 4; ++m)
#pragma unroll
                for (int n = 0; n < 2; ++n) acc[a][b][m][n] = (f32x4){0.f, 0.f, 0.f, 0.f};
    bf16x8 At[4][2], B0[2][2], B1[2][2];
    const char* cA = cur.a; const char* cB = cur.b;
    S.a_ready(cur);
    PG8_STAGE(PG8_SB(0, 0), cB, voffB); PG8_STAGE(PG8_SB(0, 1), cB + hsB, voffB); PG8_STAGE(PG8_SA(0, 0), cA, voffA); PG8_STAGE(PG8_SA(0, 1), cA + hsA, voffA);
    if (wr == 1) PG8_BAR;
    PG8_WAIT_V(2); PG8_BAR;
    PG8_STAGE(PG8_SB(1, 0), cB + kstep, voffB); PG8_STAGE(PG8_SA(1, 0), cA + kstep, voffA); PG8_STAGE(PG8_SB(1, 1), cB + hsB + kstep, voffB);
    PG8_WAIT_V(6); PG8_BAR;
    for (;;) {
        const bool has_next = S.next(ui + 1, nxt);
        const char* nA = has_next ? nxt.a : cA; const char* nB = has_next ? nxt.b : cB;
        const int nt = cur.nt; const long bjump = cur.bjump;
        for (int t = 0; t < nt; t += 2) {
            const bool last = (t == nt - 2);
            const char* a1 = cA + (size_t)(t + 1) * kstep;
            const char* a2 = last ? nA : cA + (size_t)(t + 2) * kstep; const char* b2 = last ? nB : cB + (size_t)(t + 2) * kstep + bjump;
            const char* a3 = a2 + kstep; const char* b3 = b2 + kstep;
            if (last && has_next) S.a_ready(nxt);
            PG8_LDB(B0, 0, 0); PG8_LDB(B1, 0, 1); PG8_SCHED; PG8_LDA(At, 0, 0); PG8_STAGE(PG8_SA(1, 1), a1 + hsA, voffA);
            PG8_WAIT_V(8); PG8_WAIT_L(0); PG8_BAR; PG8_MMA(0, 0, At, B0); PG8_MMA(0, 1, At, B1); PG8_BAR; PG8_SCHED;
            PG8_LDA(At, 0, 1); PG8_STAGE(PG8_SB(0, 0), b2, voffB); PG8_STAGE(PG8_SB(0, 1), b2 + hsB, voffB); PG8_STAGE(PG8_SA(0, 0), a2, voffA);
            PG8_WAIT_V(8); PG8_WAIT_L(0); PG8_BAR; PG8_MMA(1, 0, At, B0); PG8_MMA(1, 1, At, B1); PG8_BAR; PG8_SCHED;
            PG8_LDB(B0, 1, 0); PG8_LDB(B1, 1, 1); PG8_SCHED; PG8_LDA(At, 1, 0); PG8_STAGE(PG8_SA(0, 1), a2 + hsA, voffA);
            PG8_WAIT_V(8); PG8_WAIT_L(0); PG8_BAR; PG8_MMA(0, 0, At, B0); PG8_MMA(0, 1, At, B1); PG8_BAR; PG8_SCHED;
            PG8_LDA(At, 1, 1); PG8_STAGE(PG8_SB(1, 0), b3, voffB); PG8_STAGE(PG8_SB(1, 1), b3 + hsB, voffB); PG8_STAGE(PG8_SA(1, 0), a3, voffA);
            PG8_WAIT_V(8); PG8_WAIT_L(0); PG8_BAR; PG8_MMA(1, 0, At, B0); PG8_MMA(1, 1, At, B1); PG8_BAR; PG8_SCHED;
        }
        if constexpr (ALIGN_EPI) { if (wr == 0) PG8_BAR; }
        if constexpr (!Epi::AFTER_DRAIN) { E(acc, cur, wr, wc, fr, fq); S.done(cur); }
        if (!has_next) break;
#pragma unroll
        for (int a = 0; a < 2; ++a)
#pragma unroll
            for (int b = 0; b < 2; ++b)
#pragma unroll
                for (int m = 0; m < 4; ++m)
#pragma unroll
                    for (int n = 0; n < 2; ++n) acc[a][b][m][n] = (f32x4){0.f, 0.f, 0.f, 0.f};
        cur = nxt; cA = nA; cB = nB; ++ui;
        if constexpr (ALIGN_EPI) { if (wr == 1) PG8_BAR; }
    }
    PG8_WAIT_V(0);
    if constexpr (!ALIGN_EPI) { if (wr == 0) PG8_BAR; }
    PG8_BAR;
    if constexpr (Epi::AFTER_DRAIN) { E.fused(acc, cur, wr, wc, fr, fq, lds, wid, lane); S.done(cur); }
#undef PG8_SA
#undef PG8_SB
#undef PG8_STAGE
#undef PG8_LDA
#undef PG8_LDB
#undef PG8_MMA
#undef PG8_WAIT_V
#undef PG8_WAIT_L
#undef PG8_BAR
#undef PG8_SCHED
}

__device__ __forceinline__ u32x4 pack8(const f32x4 v0, const f32x4 v1) { u32x4 w; w.x = cvt_pk_bf16(v0[0], v0[1]); w.y = cvt_pk_bf16(v0[2], v0[3]); w.z = cvt_pk_bf16(v1[0], v1[1]); w.w = cvt_pk_bf16(v1[2], v1[3]); return w; }

struct EpiIn0 {
    static constexpr bool PERM = true, AFTER_DRAIN = false;
    const float* ssq; bf16_t* uperm; bf16_t* zs; bf16_t* xbc;
    __device__ __forceinline__ void operator()(const f32x4 (&acc)[2][2][4][2], const Unit& u, int wr, int wc, int fr, int fq) const {
#pragma unroll
        for (int ai = 0; ai < 2; ++ai)
#pragma unroll
            for (int m = 0; m < 4; ++m) {
                const int row = u.pm * BM + ai * HALF + wr * 64 + m * 16 + fr; const float rs = row_rstd(ssq, row);
#pragma unroll
                for (int bj = 0; bj < 2; ++bj) {
                    const int c = u.pn * BM + bj * HALF + wc * 32 + 8 * fq;
                    const u32x4 w = pack8(acc[ai][bj][m][0] * rs, acc[ai][bj][m][1] * rs);
                    bf16_t* dst;
                    if (u.pn < 2) { const int g = c >> 4, m0 = c & 15; dst = uperm + ((size_t)(g * 256 + (row >> 6)) * 1152 + 128 + (row & 63) * 16 + m0); }
                    else if (u.pn < 6) dst = zs + (size_t)row * 1024 + (c - 512);
                    else dst = xbc + (size_t)row * 1536 + (c - 1536);
                    *(u32x4*)dst = w;
                }
            }
    }
};
struct EpiS5A {
    static constexpr bool PERM = false, AFTER_DRAIN = true;
    bf16_t* uperm; const float* a64;
    __device__ __forceinline__ void operator()(const f32x4 (&)[2][2][4][2], const Unit&, int, int, int, int) const {}
    __device__ __forceinline__ void fused(f32x4 (&acc)[2][2][4][2], const Unit& u, int wr, int wc, int fr, int fq, LAS unsigned char* lds, int wid, int lane) const {
        LAS float* S = (LAS float*)lds;
#pragma unroll
        for (int ai = 0; ai < 2; ++ai)
#pragma unroll
            for (int m = 0; m < 4; ++m) { const int r = ai * HALF + wr * 64 + m * 16 + fr;
#pragma unroll
                for (int n = 0; n < 2; ++n) *(LAS f32x4*)(S + r * 128 + wc * 32 + n * 16 + 4 * fq) = acc[ai][0][m][n]; }
        LDS_WAIT(); __syncthreads();
        const int g = u.aux, tid = wid * 64 + lane, b = tid >> 6, p = tid & 63;
        const f32x2 a = *(const f32x2*)(a64 + (size_t)(g * 64 + p) * 2);
        float xr = 0.f, xi = 0.f;
        for (int c = 0; c < 32; ++c) {
            const int r = b * 32 + c;
            bf16_t* dst = uperm + (size_t)(g * 256 + r) * 1152;
            dst[p] = (bf16_t)f2bf(xr); dst[64 + p] = (bf16_t)f2bf(xi);
            const float sr = S[r * 128 + p], si = S[r * 128 + 64 + p];
            const float nr = a.x * xr - a.y * xi + sr, ni = a.x * xi + a.y * xr + si;
            xr = nr; xi = ni;
        }
        __syncthreads();
    }
};
struct EpiS5C {
    static constexpr bool PERM = true, AFTER_DRAIN = false;
    bf16_t* zg;
    __device__ __forceinline__ void operator()(const f32x4 (&acc)[2][2][4][2], const Unit& u, int wr, int wc, int fr, int fq) const {
        const int g = u.aux >> 2, i = u.aux & 3;
#pragma unroll
        for (int ai = 0; ai < 2; ++ai)
#pragma unroll
            for (int m = 0; m < 4; ++m) {
                const int r = ai * HALF + wr * 64 + m * 16 + fr;
#pragma unroll
                for (int bj = 0; bj < 2; ++bj) {
                    const int ct = bj * HALF + wc * 32 + 8 * fq, tp = ct >> 4, n0 = ct & 15;
                    f32x4 v0 = acc[ai][bj][m][0], v1 = acc[ai][bj][m][1];
#pragma unroll
                    for (int j = 0; j < 4; ++j) { v0[j] = gelu_tanh(v0[j]); v1[j] = gelu_tanh(v1[j]); }
                    *(u32x4*)(zg + ((size_t)(r * 64 + 16 * i + tp) * 512 + g * 16 + n0)) = pack8(v0, v1);
                }
            }
    }
};
struct EpiGlu {
    static constexpr bool PERM = true, AFTER_DRAIN = false;
    const bf16_t* zg; const float* bias; bf16_t* yab;
    __device__ __forceinline__ void operator()(const f32x4 (&acc)[2][2][4][2], const Unit& u, int wr, int wc, int fr, int fq) const {
#pragma unroll
        for (int bj = 0; bj < 2; ++bj) {
            const int c = u.pn * BM + bj * HALF + wc * 32 + 8 * fq;
            const f32x4 b0 = *(const f32x4*)(bias + c), b1 = *(const f32x4*)(bias + c + 4);
#pragma unroll
            for (int ai = 0; ai < 2; ++ai)
#pragma unroll
                for (int m = 0; m < 4; ++m) {
                    const int row = u.pm * BM + ai * HALF + wr * 64 + m * 16 + fr;
                    const u32x4 zw = *(const u32x4*)(zg + (size_t)row * 512 + c);
                    f32x4 v0 = acc[ai][bj][m][0] + b0, v1 = acc[ai][bj][m][1] + b1;
                    v0[0] = bflo(zw.x) * sigmoidf_(v0[0]); v0[1] = bfhi(zw.x) * sigmoidf_(v0[1]); v0[2] = bflo(zw.y) * sigmoidf_(v0[2]); v0[3] = bfhi(zw.y) * sigmoidf_(v0[3]);
                    v1[0] = bflo(zw.z) * sigmoidf_(v1[0]); v1[1] = bfhi(zw.z) * sigmoidf_(v1[1]); v1[2] = bflo(zw.w) * sigmoidf_(v1[2]); v1[3] = bfhi(zw.w) * sigmoidf_(v1[3]);
                    *(u32x4*)(yab + (size_t)row * 1536 + 1024 + c) = pack8(v0, v1);
                }
        }
    }
};
struct EpiRes {
    static constexpr bool PERM = false, AFTER_DRAIN = false;
    const float* hin; float* hout; bf16_t* hb; float* ssq;
    __device__ __forceinline__ void operator()(const f32x4 (&acc)[2][2][4][2], const Unit& u, int wr, int wc, int fr, int fq) const {
#pragma unroll
        for (int ai = 0; ai < 2; ++ai)
#pragma unroll
            for (int m = 0; m < 4; ++m) {
                const int row = u.pm * BM + ai * HALF + wr * 64 + m * 16 + fr; float ss = 0.f;
#pragma unroll
                for (int bj = 0; bj < 2; ++bj)
#pragma unroll
                    for (int n = 0; n < 2; ++n) {
                        const size_t off = (size_t)row * 1024 + u.pn * BM + bj * HALF + wc * 32 + n * 16 + 4 * fq;
                        const f32x4 h = *(const f32x4*)(hin + off) + acc[ai][bj][m][n];
                        *(f32x4*)(hout + off) = h;
                        u32x2 w; w.x = cvt_pk_bf16(h[0], h[1]); w.y = cvt_pk_bf16(h[2], h[3]); *(u32x2*)(hb + off) = w;
                        ss += (h[0] * h[0] + h[1] * h[1]) + (h[2] * h[2] + h[3] * h[3]);
                    }
                ss += __shfl_xor(ss, 16); ss += __shfl_xor(ss, 32);
                if (fq == 0) ssq[(size_t)row * 16 + u.pn * 4 + wc] = ss;
            }
    }
};
struct EpiGu {
    static constexpr bool PERM = true, AFTER_DRAIN = false;
    const float* ssq; bf16_t* hid;
    __device__ __forceinline__ void operator()(const f32x4 (&acc)[2][2][4][2], const Unit& u, int wr, int wc, int fr, int fq) const {
#pragma unroll
        for (int ai = 0; ai < 2; ++ai)
#pragma unroll
            for (int m = 0; m < 4; ++m) {
                const int row = u.pm * BM + ai * HALF + wr * 64 + m * 16 + fr; const float rs = row_rstd(ssq, row);
#pragma unroll
                for (int bj = 0; bj < 2; ++bj) {
                    const f32x4 gt = acc[ai][bj][m][0] * rs, up = acc[ai][bj][m][1] * rs;
                    u32x2 w; w.x = cvt_pk_bf16(siluf_(gt[0]) * up[0], siluf_(gt[1]) * up[1]); w.y = cvt_pk_bf16(siluf_(gt[2]) * up[2], siluf_(gt[3]) * up[3]);
                    *(u32x2*)(hid + (size_t)row * FFH + u.pn * 128 + bj * 64 + wc * 16 + 4 * fq) = w;
                }
            }
    }
};
struct EpiIn1 {
    static constexpr bool PERM = true, AFTER_DRAIN = false;
    const float* ssq; const float* rot; bf16_t* qkv;
    __device__ __forceinline__ void operator()(const f32x4 (&acc)[2][2][4][2], const Unit& u, int wr, int wc, int fr, int fq) const {
#pragma unroll
        for (int ai = 0; ai < 2; ++ai)
#pragma unroll
            for (int m = 0; m < 4; ++m) {
                const int row = u.pm * BM + ai * HALF + wr * 64 + m * 16 + fr; const float rs = row_rstd(ssq, row);
#pragma unroll
                for (int bj = 0; bj < 2; ++bj) {
                    const int c = u.pn * BM + bj * HALF + wc * 32 + 8 * fq;
                    f32x4 v0 = acc[ai][bj][m][0] * rs, v1 = acc[ai][bj][m][1] * rs;
                    if (u.pn < 4) {
                        const int i0 = (c & 127) >> 1; const float* cs = rot + ((size_t)(row & 2047) * 64 + i0) * 2;
                        const f32x4 c0 = *(const f32x4*)cs, c1 = *(const f32x4*)(cs + 4);
                        f32x4 o0, o1;
                        o0[0] = v0[0] * c0[0] - v0[1] * c0[1]; o0[1] = v0[0] * c0[1] + v0[1] * c0[0];
                        o0[2] = v0[2] * c0[2] - v0[3] * c0[3]; o0[3] = v0[2] * c0[3] + v0[3] * c0[2];
                        o1[0] = v1[0] * c1[0] - v1[1] * c1[1]; o1[1] = v1[0] * c1[1] + v1[1] * c1[0];
                        o1[2] = v1[2] * c1[2] - v1[3] * c1[3]; o1[3] = v1[2] * c1[3] + v1[3] * c1[2];
                        v0 = o0; v1 = o1;
                    }
                    *(u32x4*)(qkv + (size_t)row * 4096 + c) = pack8(v0, v1);
                }
            }
    }
};
struct EpiGate {
    static constexpr bool PERM = true, AFTER_DRAIN = false;
    const float* ssq; bf16_t* qkv;
    __device__ __forceinline__ void operator()(const f32x4 (&acc)[2][2][4][2], const Unit& u, int wr, int wc, int fr, int fq) const {
#pragma unroll
        for (int ai = 0; ai < 2; ++ai)
#pragma unroll
            for (int m = 0; m < 4; ++m) {
                const int row = u.pm * BM + ai * HALF + wr * 64 + m * 16 + fr; const float rs = row_rstd(ssq, row);
#pragma unroll
                for (int bj = 0; bj < 2; ++bj) {
                    const int c = u.pn * BM + bj * HALF + wc * 32 + 8 * fq;
                    bf16_t* p = qkv + (size_t)row * 4096 + 2048 + c;
                    const u32x4 ow = *(const u32x4*)p;
                    f32x4 v0 = acc[ai][bj][m][0] * rs, v1 = acc[ai][bj][m][1] * rs;
                    v0[0] = bflo(ow.x) * siluf_(v0[0]); v0[1] = bfhi(ow.x) * siluf_(v0[1]); v0[2] = bflo(ow.y) * siluf_(v0[2]); v0[3] = bfhi(ow.y) * siluf_(v0[3]);
                    v1[0] = bflo(ow.z) * siluf_(v1[0]); v1[1] = bfhi(ow.z) * siluf_(v1[1]); v1[2] = bflo(ow.w) * siluf_(v1[2]); v1[3] = bfhi(ow.w) * siluf_(v1[3]);
                    *(u32x4*)p = pack8(v0, v1);
                }
            }
    }
};

struct OrdS5A {
    const char* U; const char* W1; int c;
    __device__ bool next(int i, Unit& u) const {
        if (i != 0 || c < 0 || c >= 32) return false;
        u.pm = 0; u.pn = 0; u.nt = 16; u.bjump = 0; u.aux = c;
        u.a = U + ((size_t)c * 256 * 1152 + 128) * 2; u.b = W1 + (size_t)c * 128 * 1024 * 2; return true;
    }
    __device__ __forceinline__ void a_ready(const Unit&) const {}
    __device__ __forceinline__ void done(const Unit&) const {}
};
struct OrdS5C {
    const char* U; const char* BC; int c;
    __device__ bool next(int k, Unit& u) const {
        if (k != 0 || c < 0 || c >= 128) return false;
        const int g = c >> 2, i = 3 - (c & 3);
        u.pm = 0; u.pn = i; u.nt = 2 + 4 * (i + 1); u.bjump = -768L * (i + 1); u.aux = g * 4 + i;
        u.a = U + (size_t)g * 256 * 1152 * 2; u.b = BC + ((size_t)g * 256 * 1536 + 1024 + 128 * i) * 2; return true;
    }
    __device__ __forceinline__ void a_ready(const Unit&) const {}
    __device__ __forceinline__ void done(const Unit&) const {}
};

#define XB_TMO      128
#define XB_XCNT(j)  (256  + 64 * (j))
#define XB_XSUB(j)  (1280 + 64 * (j))
#define XB_XGEN(j)  (2304 + 64 * (j))
#define XB_TOP      3328
#define XB_TOPGEN   3392
#define XCD_BAR_WORDS 3456
#define XB_SPIN_CAP (1u << 18)
__device__ __forceinline__ unsigned xb_ld(unsigned* p)              { return __hip_atomic_load(p, __ATOMIC_RELAXED, __HIP_MEMORY_SCOPE_AGENT); }
__device__ __forceinline__ unsigned xb_add(unsigned* p, unsigned v) { return __hip_atomic_fetch_add(p, v, __ATOMIC_RELAXED, __HIP_MEMORY_SCOPE_AGENT); }
__device__ __forceinline__ unsigned xb_xcc_id() { return (unsigned)__builtin_amdgcn_s_getreg((3 << 11) | 20) & 0xFu; }
#define XB_SPIN(cond, bar) do { unsigned _sp = 0; while (cond) { __builtin_amdgcn_s_sleep(1); \
    if ((++_sp & 255u) == 0u) { if (xb_ld(&(bar)[XB_TMO])) break; if (_sp > XB_SPIN_CAP) { atomicAdd(&(bar)[XB_TMO], 1u); break; } } } } while (0)
struct XcdBarrier { unsigned* bar; unsigned x; volatile LAS unsigned* st; };
__device__ __forceinline__ XcdBarrier xcd_barrier_post(unsigned* bar, volatile LAS unsigned* st) {
    XcdBarrier b; b.bar = bar; b.x = xb_xcc_id(); b.st = st;
    if (threadIdx.x == 0) (void)xb_add(&bar[XB_XCNT(b.x)], 1u);
    return b;
}
__device__ __forceinline__ void xcd_barrier_complete(unsigned* bar, unsigned x, unsigned& nloc, unsigned& nx) {
    const unsigned G = gridDim.x * gridDim.y * gridDim.z;
    unsigned sum, cnt, mine, sp = 0u;
    for (;;) {
        sum = 0u; cnt = 0u; mine = 0u;
#pragma unroll
        for (unsigned j = 0; j < 16; ++j) { const unsigned c = xb_ld(&bar[XB_XCNT(j)]); sum += c; cnt += (c > 0u) ? 1u : 0u; mine = (j == x) ? c : mine; }
        if (sum == G) break;
        __builtin_amdgcn_s_sleep(1);
        if ((++sp & 255u) == 0u) { if (xb_ld(&bar[XB_TMO])) break; if (sp > XB_SPIN_CAP) { atomicAdd(&bar[XB_TMO], 1u); break; } }
    }
    nloc = mine > 0u ? mine : 1u; nx = cnt > 0u ? cnt : 1u;
}
__device__ __forceinline__ void xcd_barrier(const XcdBarrier& b) {
    asm volatile("s_waitcnt vmcnt(0)" ::: "memory");
    __syncthreads();
    if (threadIdx.x == 0) {
        unsigned* bar = b.bar;
        __builtin_amdgcn_s_waitcnt(0);
        unsigned nloc = b.st[0], nx = b.st[1];
        if (nloc == 0u) { xcd_barrier_complete(bar, b.x, nloc, nx); b.st[0] = nloc; b.st[1] = nx; }
        const unsigned old = xb_add(&bar[XB_XSUB(b.x)], 1u);
        const unsigned gen = old / nloc;
        if (old + 1u == (gen + 1u) * nloc) {
            __builtin_amdgcn_fence(__ATOMIC_RELEASE, "agent");
            asm volatile("s_waitcnt vmcnt(0)" ::: "memory");
            const unsigned og = xb_add(&bar[XB_TOP], 1u);
            const unsigned tg = og / nx;
            if (og + 1u == (tg + 1u) * nx) xb_add(&bar[XB_TOPGEN], 1u);
            else XB_SPIN(xb_ld(&bar[XB_TOPGEN]) == tg, bar);
            __builtin_amdgcn_fence(__ATOMIC_ACQUIRE, "agent");
            xb_add(&bar[XB_XGEN(b.x)], 1u);
            asm volatile("s_waitcnt vmcnt(0)" ::: "memory");
        } else {
            XB_SPIN(xb_ld(&bar[XB_XGEN(b.x)]) == gen, bar);
            __builtin_amdgcn_fence(__ATOMIC_ACQUIRE, "agent");
            asm volatile("s_waitcnt vmcnt(0)" ::: "memory");
        }
    }
    __syncthreads();
}

constexpr int RING_BYTES = 131072, LDSCTL_OFF = RING_BYTES, MISC_OFF = LDSCTL_OFF + 320, LDS_BYTES = 147456;
constexpr int NPH = 16;
struct Args { const float* in[31]; float* out; unsigned char* ws; int ph_lo, ph_hi; };

template <class F>
__device__ __forceinline__ void transpose_item(const F& f, bf16_t* WT, int K, int item, int nblk, LAS float* scr, int lane) {
    const int kb = item / nblk, nb = item % nblk, k0 = 64 * kb, n0 = 32 * nb;
#pragma unroll 8
    for (int i = 0; i < 32; ++i) { const int kk = 2 * i + (lane >> 5); scr[kk * 33 + (lane & 31)] = f.val(k0 + kk, n0 + (lane & 31)); }
    LDS_WAIT(); asm volatile("" ::: "memory");
    const int c = lane & 7;
#pragma unroll
    for (int j = 0; j < 4; ++j) { const int n = (lane >> 3) + 8 * j; const LAS float* s = scr + (8 * c) * 33 + n;
        u32x4 o; o.x = pk2(s[0 * 33], s[1 * 33]); o.y = pk2(s[2 * 33], s[3 * 33]); o.z = pk2(s[4 * 33], s[5 * 33]); o.w = pk2(s[6 * 33], s[7 * 33]);
        *(u32x4*)(WT + (size_t)(n0 + n) * K + k0 + 8 * c) = o; }
    LDS_WAIT(); asm volatile("" ::: "memory");
}
template <class F>
__device__ __forceinline__ void transpose_all(const F& f, bf16_t* WT, int K, int Npad, LAS float* scr, int lane, int gw, int ngw) {
    const int nblk = Npad / 32, nitems = (K / 64) * nblk;
    for (int it = gw; it < nitems; it += ngw) transpose_item(f, WT, K, it, nblk, scr, lane);
}
struct FIn0 { const float* w; const float* g; __device__ __forceinline__ float val(int k, int n) const { return w[(size_t)k * EVEN_IN + n] * g[k]; } };
struct FDt0 { const float* w; const float* g; __device__ __forceinline__ float val(int k, int n) const { return n < 16 ? w[(size_t)k * EVEN_IN + 3072 + n] * g[k] : 0.f; } };
struct FPlain { const float* w; int N; __device__ __forceinline__ float val(int k, int n) const { return w[(size_t)k * N + n]; } };
struct FOut0 { const float* w; const float* g; __device__ __forceinline__ float val(int k, int n) const { return k < 1024 ? w[(size_t)(512 + k) * 1024 + n] * g[k] : w[(size_t)(k - 1024) * 1024 + n]; } };
struct FGu { const float* wg; const float* wu; const float* g; __device__ __forceinline__ float val(int k, int n) const {
    const int tile = n >> 8, q = n & 255, j = tile * 128 + (q >> 3) * 4 + (q & 3); const long dlt = (q & 4) ? (long)(wu - wg) : 0L; return wg[dlt + (long)k * FFH + j] * g[k]; } };
struct FIn1 { const float* w; const float* g; __device__ __forceinline__ float val(int k, int n) const {
    int col; float sc = 1.f;
    if (n < 1024) { const int head = (n & 511) >> 7, pc = n & 127, i = pc >> 1, d = (pc & 1) ? i + 64 : i; col = (n < 512 ? 0 : 512) + head * 128 + d; if (n >= 512) sc = 0.08838834764831845f; }
    else if (n < 1536) { col = 3072 + (n - 1024); sc = 0.08838834764831845f; }
    else if (n < 2048) col = 3584 + (n - 1536);
    else if (n < 3072) col = 1024 + (n - 2048);
    else col = 4096 + (n - 3072);
    return w[(size_t)k * ODD_IN + col] * g[k] * sc; } };
struct FAlr { const float* w; const float* g; __device__ __forceinline__ float val(int k, int n) const { return n < 16 ? w[(size_t)k * ODD_IN + 5120 + n] * g[k] : 0.f; } };
struct FGate { const float* w; const float* g; __device__ __forceinline__ float val(int k, int n) const { const int col = n < 1024 ? 2048 + n : 5136 + (n - 1024); return w[(size_t)k * ODD_IN + col] * g[k]; } };
struct FOut1 { const float* w; const float* gr; const float* gg; __device__ __forceinline__ float val(int k, int n) const { return w[(size_t)k * 1024 + n] * (k < 1024 ? gr[k] : gg[k - 1024]); } };

__device__ __forceinline__ void s5_tables_part(const Args& A, unsigned char* ws, LAS unsigned char* lds, int g, int lb, int tid) {
    LAS f32x2* apow = (LAS f32x2*)lds;
    LAS f32x2* Cc = apow + 9 * 64;
    LAS f32x2* Bb = Cc + 1024;
    const float* lam_re = A.in[5] + g * 64; const float* lam_im = A.in[6] + g * 64;
    const float step = expf(A.in[7][g]);
    const float* b_re = A.in[8] + (size_t)g * 1024; const float* b_im = A.in[9] + (size_t)g * 1024;
    const float* c_re = A.in[10] + (size_t)g * 1024; const float* c_im = A.in[11] + (size_t)g * 1024;
    const float* dsk = A.in[12] + g * 16;
    for (int idx = tid; idx < 9 * 64; idx += NTHREADS) { const int lag = 8 * lb + (idx >> 6), p = idx & 63; const float lr = lam_re[p], li = lam_im[p];
        const float mag = expf((float)lag * (lr * step)), ang = (float)lag * (li * step); float sn, cs; sincosf(ang, &sn, &cs); apow[idx] = (f32x2){mag * cs, mag * sn}; }
    for (int idx = tid; idx < 1024; idx += NTHREADS) { Cc[idx] = (f32x2){c_re[idx], c_im[idx]};
        const int p = idx >> 4; const float lr = lam_re[p], li = lam_im[p]; const float mag = expf(lr * step); float sn, cs; sincosf(li * step, &sn, &cs);
        const float ar = mag * cs, ai = mag * sn, den = lr * lr + li * li, kr = ((ar - 1.f) * lr + ai * li) / den, ki = (ai * lr - (ar - 1.f) * li) / den;
        const float br = b_re[idx], bi = b_im[idx]; Bb[idx] = (f32x2){kr * br - ki * bi, kr * bi + ki * br}; }
    __syncthreads();
    float* kt = (float*)(ws + WS_S5K) + (size_t)(g * 64 + 8 * lb) * 256;
    for (int idx = tid; idx < 2048; idx += NTHREADS) { const int l = idx >> 8, n = (idx >> 4) & 15, m = idx & 15; float sacc = 0.f;
#pragma unroll 8
        for (int p = 0; p < 64; ++p) { const f32x2 c = Cc[n * 64 + p], a = apow[l * 64 + p], b = Bb[p * 16 + m];
            const float tr = c.x * a.x - c.y * a.y, ti = c.x * a.y + c.y * a.x; sacc += tr * b.x - ti * b.y; }
        if (lb == 0 && l == 0 && n == m) sacc += dsk[n];
        kt[idx] = sacc; }
    {
        const int i = lb >> 1, tp0 = 8 * (lb & 1);
        unsigned* bc = (unsigned*)(ws + WS_S5BC) + (size_t)g * 256 * 768;
        for (int idx = tid; idx < 128 * 64; idx += NTHREADS) { const int rr = idx >> 6, c2 = (idx & 63) * 2, tp = tp0 + (rr >> 4), n = rr & 15, l = tp - tp0 + 1; float v[2];
#pragma unroll
            for (int e = 0; e < 2; ++e) { const int pp = c2 + e, p = pp & 63; const f32x2 cc = Cc[n * 64 + p], a = apow[l * 64 + p];
                v[e] = pp < 64 ? (cc.x * a.x - cc.y * a.y) : -(cc.x * a.y + cc.y * a.x); }
            bc[(size_t)(tp * 16 + n) * 768 + (1024 + 128 * i + c2) / 2] = pk2(v[0], v[1]); }
    }
    {
        unsigned* w1 = (unsigned*)(ws + WS_S5W1) + (size_t)g * 128 * 512;
        for (int idx = tid; idx < 128 * 64; idx += NTHREADS) { const int pp = idx >> 6, q = idx & 63, l = q >> 3, m2 = (q & 7) * 2, sidx = 63 - 8 * lb - l, p = pp & 63; float v[2];
#pragma unroll
            for (int e = 0; e < 2; ++e) { const f32x2 a = apow[l * 64 + p], b = Bb[p * 16 + m2 + e]; v[e] = pp < 64 ? (a.x * b.x - a.y * b.y) : (a.x * b.y + a.y * b.x); }
            w1[(size_t)pp * 512 + (sidx * 16 + m2) / 2] = pk2(v[0], v[1]); }
    }
    if (lb == 7 && tid < 64) *(f32x2*)((float*)(ws + WS_A64) + (size_t)(g * 64 + tid) * 2) = apow[8 * 64 + tid];
    __syncthreads();
}
__device__ __forceinline__ void s5_expand(unsigned char* ws, int gtid, int ngt) {
    const float* kt = (const float*)(ws + WS_S5K); unsigned* bc = (unsigned*)(ws + WS_S5BC);
    for (int idx = gtid; idx < 32 * 256 * 512; idx += ngt) {
        const int g = idx >> 17, r = (idx >> 9) & 255, c2 = (idx & 511) * 2, tp = r >> 4, n = r & 15, d = 3 - (c2 >> 8), kk = c2 & 255, sp = kk >> 4, m = kk & 15, lag = 16 * d + tp - sp;
        unsigned w = 0u;
        if (lag >= 0) { const f32x2 v = *(const f32x2*)(kt + (size_t)(g * 64 + lag) * 256 + n * 16 + m); w = pk2(v.x, v.y); }
        bc[(size_t)(g * 256 + r) * 768 + (c2 >> 1)] = w;
    }
}

__device__ __forceinline__ void skinny16(const bf16_t* hb, const bf16_t* wt, const float* ssq, float* out, int gw, int ngw, int lane) {
    for (int task = gw; task < T / 16; task += ngw) {
        const int r0 = task * 16; f32x4 acc = (f32x4){0.f, 0.f, 0.f, 0.f};
        const bf16_t* ap = hb + (size_t)(r0 + (lane & 15)) * 1024 + (lane >> 4) * 8; const bf16_t* bp = wt + (size_t)(lane & 15) * 1024 + (lane >> 4) * 8;
#pragma unroll 4
        for (int kk = 0; kk < 32; ++kk) { const bf16x8 a = *(const bf16x8*)(ap + kk * 32), b = *(const bf16x8*)(bp + kk * 32); acc = __builtin_amdgcn_mfma_f32_16x16x32_bf16(a, b, acc, 0, 0, 0); }
#pragma unroll
        for (int j = 0; j < 4; ++j) { const int row = r0 + (lane >> 4) * 4 + j; out[(size_t)row * 16 + (lane & 15)] = acc[j] * row_rstd(ssq, row); }
    }
}

template <int STRIDE>
__device__ __forceinline__ bf16x8 ldfrag(const LAS unsigned char* base, int row0, int k0, int lane) {
    return *(const LAS bf16x8*)(base + (row0 + (lane & 15)) * STRIDE + (k0 + (lane >> 4) * 8) * 2);
}
#define MFMA16(a, b, c) __builtin_amdgcn_mfma_f32_16x16x32_bf16(a, b, c, 0, 0, 0)
__device__ __forceinline__ u32x2 pack4(const f32x4 v) { u32x2 w; w.x = cvt_pk_bf16(v[0], v[1]); w.y = cvt_pk_bf16(v[2], v[3]); return w; }
__device__ __forceinline__ u32x4 pack8f(const float (&v)[8]) { u32x4 w; w.x = cvt_pk_bf16(v[0], v[1]); w.y = cvt_pk_bf16(v[2], v[3]); w.z = cvt_pk_bf16(v[4], v[5]); w.w = cvt_pk_bf16(v[6], v[7]); return w; }

constexpr int M1_QP = 0, M1_KN = 17408, M1_KDT = 34816, M1_VT = 53248, M1_P = 62464, M1_ST = 71680, M1_XCH = 106496, M1_EDEC = 110592;
__device__ __forceinline__ void mix1_item(LAS unsigned char* lds, unsigned char* ws, int item, int wave, int lane) {
    const int mixer = item >> 7, b = (item >> 4) & 7, h = (item >> 2) & 3, vq = item & 3;
    const bf16_t* qkv = (const bf16_t*)(ws + WS_QKV); const bf16_t* loga = (const bf16_t*)(ws + WS_LOGA);
    bf16_t* out = (bf16_t*)(ws + WS_QKV);
    const int qoff = (mixer ? 1024 : 0) + h * 128 + 2 * lane, koff = qoff + 512, vcol = 2048 + (mixer ? 1024 : 0) + h * 256 + vq * 64;
    const float lgam = logf(1.0f - exp2f(-5.0f - (float)h));
    const int mt = wave >> 1, nt0 = (wave & 1) * 2, dt0 = (wave & 1) * 4;
    f32x4 accs[4], o0 = (f32x4){0.f, 0.f, 0.f, 0.f}, o1 = o0;
#pragma unroll
    for (int i = 0; i < 4; ++i) accs[i] = (f32x4){0.f, 0.f, 0.f, 0.f};
    unsigned qr[2][8], kr[2][8], lr[2][8], vr[2][8];
#define M1_LOAD(c, u) do { _Pragma("unroll") for (int t = 0; t < 8; ++t) { const size_t row = (size_t)b * SEQ + (c) * 64 + 8 * wave + t; const bf16_t* rp = qkv + row * 4096; \
        qr[u][t] = *(const unsigned*)(rp + qoff); kr[u][t] = *(const unsigned*)(rp + koff); vr[u][t] = rp[vcol + lane]; \
        lr[u][t] = mixer ? *(const unsigned*)(loga + row * 512 + h * 128 + 2 * lane) : 0u; } } while (0)
    M1_LOAD(0, 0); M1_LOAD(1, 1);
    for (int c2 = 0; c2 < 16; ++c2) {
#pragma unroll
      for (int u = 0; u < 2; ++u) {
        const int c = 2 * c2 + u;
        const int cur = u, nxt = u ^ 1;
        float c0[8], c1[8], run0 = 0.f, run1 = 0.f;
#pragma unroll
        for (int t = 0; t < 8; ++t) { const float la0 = mixer ? bflo(lr[u][t]) : lgam, la1 = mixer ? bfhi(lr[u][t]) : lgam; run0 += la0; run1 += la1; c0[t] = run0; c1[t] = run1; }
        *(LAS f32x2*)(lds + M1_XCH + (wave * 128 + 2 * lane) * 4) = (f32x2){run0, run1};
        __syncthreads();
        float pre0 = 0.f, pre1 = 0.f, tot0 = 0.f, tot1 = 0.f;
#pragma unroll
        for (int w2 = 0; w2 < 8; ++w2) { const f32x2 x = *(const LAS f32x2*)(lds + M1_XCH + (w2 * 128 + 2 * lane) * 4); tot0 += x.x; tot1 += x.y; if (w2 < wave) { pre0 += x.x; pre1 += x.y; } }
        float kd0[8], kd1[8];
#pragma unroll
        for (int t = 0; t < 8; ++t) {
            const float b0 = pre0 + c0[t], b1 = pre1 + c1[t];
            const float ep0 = __expf(b0), ep1 = __expf(b1), en0 = __expf(-b0), en1 = __expf(-b1), ed0 = __expf(tot0 - b0), ed1 = __expf(tot1 - b1);
            const float q0 = bflo(qr[u][t]), q1 = bfhi(qr[u][t]), k0 = bflo(kr[u][t]), k1 = bfhi(kr[u][t]);
            *(LAS unsigned*)(lds + M1_QP + (8 * wave + t) * 272 + 4 * lane) = cvt_pk_bf16(q0 * ep0, q1 * ep1);
            *(LAS unsigned*)(lds + M1_KN + (8 * wave + t) * 272 + 4 * lane) = cvt_pk_bf16(k0 * en0, k1 * en1);
            kd0[t] = k0 * ed0; kd1[t] = k1 * ed1;
        }
        *(LAS u32x4*)(lds + M1_KDT + (2 * lane) * 144 + 16 * wave) = pack8f(kd0);
        *(LAS u32x4*)(lds + M1_KDT + (2 * lane + 1) * 144 + 16 * wave) = pack8f(kd1);
        if (wave == 0) *(LAS f32x2*)(lds + M1_EDEC + 8 * lane) = (f32x2){__expf(tot0), __expf(tot1)};
        { u32x4 vv; vv.x = vr[u][0] | (vr[u][1] << 16); vv.y = vr[u][2] | (vr[u][3] << 16); vv.z = vr[u][4] | (vr[u][5] << 16); vv.w = vr[u][6] | (vr[u][7] << 16); *(LAS u32x4*)(lds + M1_VT + lane * 144 + 16 * wave) = vv; }
        if (c + 2 < 32) M1_LOAD(c + 2, u);
        __syncthreads();
        bf16x8 qa[4];
#pragma unroll
        for (int ks = 0; ks < 4; ++ks) qa[ks] = ldfrag<272>(lds + M1_QP, 16 * mt, 32 * ks, lane);
        f32x4 p0 = (f32x4){0.f, 0.f, 0.f, 0.f}, p1 = p0;
#pragma unroll
        for (int ks = 0; ks < 4; ++ks) { const bf16x8 k0f = ldfrag<272>(lds + M1_KN, 16 * nt0, 32 * ks, lane), k1f = ldfrag<272>(lds + M1_KN, 16 * (nt0 + 1), 32 * ks, lane);
            p0 = MFMA16(k0f, qa[ks], p0); p1 = MFMA16(k1f, qa[ks], p1); }
        const int ii = 16 * mt + (lane & 15);
        { const int j0 = 16 * nt0 + 4 * (lane >> 4), j1 = j0 + 16;
#pragma unroll
          for (int r = 0; r < 4; ++r) { if (j0 + r > ii) p0[r] = 0.f; if (j1 + r > ii) p1[r] = 0.f; }
          *(LAS u32x2*)(lds + M1_P + ii * 144 + j0 * 2) = pack4(p0); *(LAS u32x2*)(lds + M1_P + ii * 144 + j1 * 2) = pack4(p1); }
        if (c > 0) {
#pragma unroll
            for (int ks = 0; ks < 4; ++ks) { const bf16x8 s0 = ldfrag<272>(lds + M1_ST + cur * 17408, 16 * nt0, 32 * ks, lane), s1 = ldfrag<272>(lds + M1_ST + cur * 17408, 16 * (nt0 + 1), 32 * ks, lane);
                o0 = MFMA16(s0, qa[ks], o0); o1 = MFMA16(s1, qa[ks], o1); }
        }
#pragma unroll
        for (int dtl = 0; dtl < 4; ++dtl) { const f32x4 e = *(const LAS f32x4*)(lds + M1_EDEC + (16 * (dt0 + dtl) + 4 * (lane >> 4)) * 4); accs[dtl] = accs[dtl] * e; }
#pragma unroll
        for (int ks = 0; ks < 2; ++ks) { const bf16x8 va = ldfrag<144>(lds + M1_VT, 16 * mt, 32 * ks, lane);
#pragma unroll
            for (int dtl = 0; dtl < 4; ++dtl) { const bf16x8 kb = ldfrag<144>(lds + M1_KDT, 16 * (dt0 + dtl), 32 * ks, lane); accs[dtl] = MFMA16(kb, va, accs[dtl]); } }
#pragma unroll
        for (int dtl = 0; dtl < 4; ++dtl) *(LAS u32x2*)(lds + M1_ST + nxt * 17408 + ii * 272 + (16 * (dt0 + dtl) + 4 * (lane >> 4)) * 2) = pack4(accs[dtl]);
        __syncthreads();
#pragma unroll
        for (int ks = 0; ks < 2; ++ks) { const bf16x8 pa = ldfrag<144>(lds + M1_P, 16 * mt, 32 * ks, lane), v0 = ldfrag<144>(lds + M1_VT, 16 * nt0, 32 * ks, lane), v1 = ldfrag<144>(lds + M1_VT, 16 * (nt0 + 1), 32 * ks, lane);
            o0 = MFMA16(v0, pa, o0); o1 = MFMA16(v1, pa, o1); }
        { bf16_t* op = out + ((size_t)b * SEQ + c * 64 + ii) * 4096 + vcol + 16 * nt0 + 4 * (lane >> 4);
          *(u32x2*)op = pack4(o0); *(u32x2*)(op + 16) = pack4(o1); }
        o0 = (f32x4){0.f, 0.f, 0.f, 0.f}; o1 = o0;
      }
    }
    __syncthreads();
#undef M1_LOAD
}

constexpr int S_CA = 0, S_CP = 9216, S_BN = 18432, S_BDT = 27648, S_XT = 36864, S_XS = 46080, S_P = 55296, S_ST = 64512;
__device__ __forceinline__ void ssd_item(LAS unsigned char* lds, unsigned char* ws, const float* cw, const float* cb, float dt_bias, float aneg, float dsk, int item, int wave, int lane) {
    const int b = item >> 4, h = item & 15, g = h >> 2;
    const bf16_t* xbc = (const bf16_t*)(ws + WS_XBC); const bf16_t* zs = (const bf16_t*)(ws + WS_ZS); const float* dtb = (const float*)(ws + WS_DT);
    bf16_t* yab = (bf16_t*)(ws + WS_YAB); float* ssqb = (float*)(ws + WS_SSQB);
    const int cx = h * 64 + lane, cB = 1024 + g * 64 + lane, cC = 1280 + g * 64 + lane;
    float wx[4], wb[4], wc_[4];
#pragma unroll
    for (int k = 0; k < 4; ++k) { wx[k] = cw[k * 1536 + cx]; wb[k] = cw[k * 1536 + cB]; wc_[k] = cw[k * 1536 + cC]; }
    const float bx_ = cb[cx], bb_ = cb[cB], bc_ = cb[cC];
    const int mt = wave >> 1, nt0 = (wave & 1) * 2;
    f32x4 accs0 = (f32x4){0.f, 0.f, 0.f, 0.f}, accs1 = accs0, o0 = accs0, o1 = accs0;
    unsigned xr[2][11], br[2][11], cr[2][11]; float dtr[2];
#define SSD_LOAD(c, u) do { _Pragma("unroll") for (int rr = 0; rr < 11; ++rr) { const int trow = (c) * 64 + 8 * wave - 3 + rr; \
        if (trow >= 0) { const bf16_t* rp = xbc + ((size_t)b * SEQ + trow) * 1536; xr[u][rr] = rp[cx]; br[u][rr] = rp[cB]; cr[u][rr] = rp[cC]; } else { xr[u][rr] = 0u; br[u][rr] = 0u; cr[u][rr] = 0u; } } \
        dtr[u] = dtb[((size_t)b * SEQ + (c) * 64 + lane) * 16 + h]; } while (0)
    SSD_LOAD(0, 0); SSD_LOAD(1, 1);
    for (int c2 = 0; c2 < 16; ++c2) {
#pragma unroll
      for (int u = 0; u < 2; ++u) {
        const int c = 2 * c2 + u;
        const int cur = u, nxt = u ^ 1;
        const size_t row0 = (size_t)b * SEQ + c * 64;
        const int ii = 16 * mt + (lane & 15);
        const u32x2 z0 = *(const u32x2*)(zs + (row0 + ii) * 1024 + h * 64 + 16 * nt0 + 4 * (lane >> 4)), z1 = *(const u32x2*)(zs + (row0 + ii) * 1024 + h * 64 + 16 * nt0 + 16 + 4 * (lane >> 4));
        const float dr = dtr[u] + dt_bias, dt = dr > 20.f ? dr : log1pf(__expf(dr));
        float acum = aneg * dt;
#pragma unroll
        for (int o = 1; o < 64; o <<= 1) { const float v = __shfl_up(acum, o); if (lane >= o) acum += v; }
        const float a63 = __int_as_float(__builtin_amdgcn_readlane(__float_as_int(acum), 63));
        float xd[8], bd[8];
#pragma unroll
        for (int t = 0; t < 8; ++t) {
            const int tok = 8 * wave + t;
            const float dt_t = __int_as_float(__builtin_amdgcn_readlane(__float_as_int(dt), tok)), ac_t = __int_as_float(__builtin_amdgcn_readlane(__float_as_int(acum), tok));
            float xv = bx_, bv = bb_, cv = bc_;
#pragma unroll
            for (int k = 0; k < 4; ++k) { xv += wx[k] * bf2f(xr[u][t + k]); bv += wb[k] * bf2f(br[u][t + k]); cv += wc_[k] * bf2f(cr[u][t + k]); }
            xv = siluf_(xv); bv = siluf_(bv); cv = siluf_(cv);
            xd[t] = xv * dt_t; bd[t] = bv * __expf(a63 - ac_t);
            *(LAS bf16_t*)(lds + S_XS + tok * 144 + 2 * lane) = (bf16_t)f2bf(xv);
            *(LAS bf16_t*)(lds + S_BN + tok * 144 + 2 * lane) = (bf16_t)f2bf(bv);
            *(LAS bf16_t*)(lds + S_CA + tok * 144 + 2 * lane) = (bf16_t)f2bf(cv);
            *(LAS bf16_t*)(lds + S_CP + tok * 144 + 2 * lane) = (bf16_t)f2bf(cv * __expf(ac_t));
        }
        *(LAS u32x4*)(lds + S_XT + lane * 144 + 16 * wave) = pack8f(xd);
        *(LAS u32x4*)(lds + S_BDT + lane * 144 + 16 * wave) = pack8f(bd);
        if (c + 2 < 32) SSD_LOAD(c + 2, u);
        __syncthreads();
        bf16x8 ca[2];
#pragma unroll
        for (int ks = 0; ks < 2; ++ks) ca[ks] = ldfrag<144>(lds + S_CA, 16 * mt, 32 * ks, lane);
        f32x4 p0 = (f32x4){0.f, 0.f, 0.f, 0.f}, p1 = p0;
#pragma unroll
        for (int ks = 0; ks < 2; ++ks) { const bf16x8 b0f = ldfrag<144>(lds + S_BN, 16 * nt0, 32 * ks, lane), b1f = ldfrag<144>(lds + S_BN, 16 * (nt0 + 1), 32 * ks, lane);
            p0 = MFMA16(b0f, ca[ks], p0); p1 = MFMA16(b1f, ca[ks], p1); }
        { const float al = __shfl(acum, ii); const int j0 = 16 * nt0 + 4 * (lane >> 4), j1 = j0 + 16;
#pragma unroll
          for (int r = 0; r < 4; ++r) { const float as0 = __shfl(acum, j0 + r), as1 = __shfl(acum, j1 + r);
              p0[r] = (j0 + r <= ii) ? p0[r] * __expf(al - as0) : 0.f; p1[r] = (j1 + r <= ii) ? p1[r] * __expf(al - as1) : 0.f; }
          *(LAS u32x2*)(lds + S_P + ii * 144 + j0 * 2) = pack4(p0); *(LAS u32x2*)(lds + S_P + ii * 144 + j1 * 2) = pack4(p1); }
        if (c > 0) {
#pragma unroll
            for (int ks = 0; ks < 2; ++ks) { const bf16x8 cp = ldfrag<144>(lds + S_CP, 16 * mt, 32 * ks, lane), s0 = ldfrag<144>(lds + S_ST + cur * 9216, 16 * nt0, 32 * ks, lane), s1 = ldfrag<144>(lds + S_ST + cur * 9216, 16 * (nt0 + 1), 32 * ks, lane);
                o0 = MFMA16(s0, cp, o0); o1 = MFMA16(s1, cp, o1); }
        }
        { const float e63 = __expf(a63); accs0 = accs0 * e63; accs1 = accs1 * e63; }
#pragma unroll
        for (int ks = 0; ks < 2; ++ks) { const bf16x8 xa = ldfrag<144>(lds + S_XT, 16 * mt, 32 * ks, lane), n0 = ldfrag<144>(lds + S_BDT, 16 * nt0, 32 * ks, lane), n1 = ldfrag<144>(lds + S_BDT, 16 * (nt0 + 1), 32 * ks, lane);
            accs0 = MFMA16(n0, xa, accs0); accs1 = MFMA16(n1, xa, accs1); }
        *(LAS u32x2*)(lds + S_ST + nxt * 9216 + ii * 144 + (16 * nt0 + 4 * (lane >> 4)) * 2) = pack4(accs0);
        *(LAS u32x2*)(lds + S_ST + nxt * 9216 + ii * 144 + (16 * nt0 + 16 + 4 * (lane >> 4)) * 2) = pack4(accs1);
        __syncthreads();
#pragma unroll
        for (int ks = 0; ks < 2; ++ks) { const bf16x8 pa = ldfrag<144>(lds + S_P, 16 * mt, 32 * ks, lane), x0 = ldfrag<144>(lds + S_XT, 16 * nt0, 32 * ks, lane), x1 = ldfrag<144>(lds + S_XT, 16 * (nt0 + 1), 32 * ks, lane);
            o0 = MFMA16(x0, pa, o0); o1 = MFMA16(x1, pa, o1); }
        { const int pc0 = 16 * nt0 + 4 * (lane >> 4);
          const u32x2 xs0 = *(const LAS u32x2*)(lds + S_XS + ii * 144 + pc0 * 2), xs1 = *(const LAS u32x2*)(lds + S_XS + ii * 144 + (pc0 + 16) * 2);
          f32x4 y0, y1;
          y0[0] = (o0[0] + dsk * bflo(xs0.x)) * siluf_(bflo(z0.x)); y0[1] = (o0[1] + dsk * bfhi(xs0.x)) * siluf_(bfhi(z0.x)); y0[2] = (o0[2] + dsk * bflo(xs0.y)) * siluf_(bflo(z0.y)); y0[3] = (o0[3] + dsk * bfhi(xs0.y)) * siluf_(bfhi(z0.y));
          y1[0] = (o1[0] + dsk * bflo(xs1.x)) * siluf_(bflo(z1.x)); y1[1] = (o1[1] + dsk * bfhi(xs1.x)) * siluf_(bfhi(z1.x)); y1[2] = (o1[2] + dsk * bflo(xs1.y)) * siluf_(bflo(z1.y)); y1[3] = (o1[3] + dsk * bfhi(xs1.y)) * siluf_(bfhi(z1.y));
          float ss = ((y0[0] * y0[0] + y0[1] * y0[1]) + (y0[2] * y0[2] + y0[3] * y0[3])) + ((y1[0] * y1[0] + y1[1] * y1[1]) + (y1[2] * y1[2] + y1[3] * y1[3]));
          ss += __shfl_xor(ss, 16); ss += __shfl_xor(ss, 32);
          bf16_t* op = yab + (row0 + ii) * 1536 + h * 64 + pc0;
          *(u32x2*)op = pack4(y0); *(u32x2*)(op + 16) = pack4(y1);
          if (lane < 16) ssqb[(row0 + ii) * 32 + h * 2 + (wave & 1)] = ss; }
        o0 = (f32x4){0.f, 0.f, 0.f, 0.f}; o1 = o0;
        __syncthreads();
      }
    }
#undef SSD_LOAD
}

__device__ __forceinline__ void skinny_loga(const bf16_t* hb, const bf16_t* wt, const float* ssq, const float* gwt, const float* gbs, bf16_t* loga, int gw, int ngw, int lane) {
    for (int task2 = gw; task2 < T / 8; task2 += ngw) {
        const int task = task2 >> 1, half = task2 & 1;
        const int r0 = task * 16; f32x4 acc = (f32x4){0.f, 0.f, 0.f, 0.f};
        const bf16_t* ap = hb + (size_t)(r0 + (lane & 15)) * 1024 + (lane >> 4) * 8; const bf16_t* bp = wt + (size_t)(lane & 15) * 1024 + (lane >> 4) * 8;
#pragma unroll 4
        for (int kk = 0; kk < 32; ++kk) { const bf16x8 a = *(const bf16x8*)(ap + kk * 32), b = *(const bf16x8*)(bp + kk * 32); acc = MFMA16(a, b, acc); }
#pragma unroll
        for (int j = 0; j < 4; ++j) acc[j] *= row_rstd(ssq, r0 + (lane >> 4) * 4 + j);
        {
            float z[8][8];
#pragma unroll
            for (int m = 0; m < 8; ++m) { const float bsv = gbs[lane + 64 * m];
#pragma unroll
                for (int rr = 0; rr < 8; ++rr) z[rr][m] = bsv; }
            for (int r = 0; r < 16; ++r) {
                float gv[8];
#pragma unroll
                for (int m = 0; m < 8; ++m) gv[m] = gwt[r * 512 + lane + 64 * m];
#pragma unroll
                for (int rr = 0; rr < 8; ++rr) { const float sv = __int_as_float(__builtin_amdgcn_readlane(__float_as_int(acc[rr & 3]), r + 16 * (2 * half + (rr >> 2))));
#pragma unroll
                    for (int m = 0; m < 8; ++m) z[rr][m] += sv * gv[m]; }
            }
#pragma unroll
            for (int rr = 0; rr < 8; ++rr)
#pragma unroll
                for (int m = 0; m < 8; ++m) { const float zz = z[rr][m], la = (fminf(zz, 0.f) - __logf(1.0f + __expf(-fabsf(zz)))) * 0.0625f;
                    loga[(size_t)(r0 + 8 * half + rr) * 512 + lane + 64 * m] = (bf16_t)f2bf(la); }
        }
    }
}

__global__ void __launch_bounds__(NTHREADS, 2) mega_fwd(Args args) {
    extern __shared__ __attribute__((aligned(16))) unsigned char lds_raw[];
    LAS unsigned char* lds = (LAS unsigned char*)lds_raw;
    volatile LAS unsigned* MISC = (volatile LAS unsigned*)(lds + MISC_OFF);
    const int tid = threadIdx.x, lane = tid & 63, wave = __builtin_amdgcn_readfirstlane(tid >> 6);
    const int G = gridDim.x, bx = blockIdx.x;
    const int vcu = (G % 8 == 0) ? (bx % 8) * (G / 8) + bx / 8 : bx;
    const int gw = vcu * NWAVES + wave, NGW = G * NWAVES;
    const int gtid = gw * 64 + lane, NGT = NGW * 64;
    unsigned char* ws = args.ws;
    for (int u = tid; u < (LDS_BYTES - LDSCTL_OFF) / 4; u += NTHREADS) ((LAS unsigned*)(lds + LDSCTL_OFF))[u] = 0u;
    __syncthreads();
    XcdBarrier bar; bar.bar = (unsigned*)(ws + WS_CTL) + CW_BAR; bar.x = 0; bar.st = nullptr;
    if (!MK_PER_PHASE) bar = xcd_barrier_post((unsigned*)(ws + WS_CTL) + CW_BAR, MISC + 8);
    const int lo = args.ph_lo, hi = args.ph_hi;
#define IN(k) (lo <= (k) && (k) < hi)
#define SEAM(k) do { if (IN(k) && IN((k) + 1)) xcd_barrier(bar); } while (0)

    float* hres = args.out;
    float* ssq = (float*)(ws + WS_SSQ);
    bf16_t* hb = (bf16_t*)(ws + WS_HB);

    if (IN(0)) {
        LAS float* scr = (LAS float*)(lds + wave * 16384);
        for (int it = bx; it < 256; it += G) s5_tables_part(args, ws, lds, it >> 3, it & 7, tid);
        { FIn0 f{args.in[4], args.in[1]}; transpose_all(f, (bf16_t*)(ws + WS_W0IN), 1024, 3072, scr, lane, gw, NGW); }
        { FDt0 f{args.in[4], args.in[1]}; transpose_all(f, (bf16_t*)(ws + WS_W0DT), 1024, 32, scr, lane, gw, NGW); }
        { FPlain f{args.in[13], 512}; transpose_all(f, (bf16_t*)(ws + WS_W0GLU), 512, 512, scr, lane, gw, NGW); }
        float* rot = (float*)(ws + WS_ROT);
        for (int idx = gtid; idx < 2048 * 64; idx += NGT) { const int l = idx >> 6, i = idx & 63; const float invf = powf(10000.0f, -(float)i / 64.0f), ang = (float)l * invf; float sn, cs; sincosf(ang, &sn, &cs);
            *(f32x2*)(rot + (size_t)idx * 2) = (f32x2){cs, sn}; }
        const float* x = args.in[0];
        for (int row = gw; row < T; row += NGW) {
            const f32x4* xr = (const f32x4*)(x + (size_t)row * 1024) + lane; float s = 0.f; f32x4 v[4];
#pragma unroll
            for (int j = 0; j < 4; ++j) { v[j] = xr[64 * j]; s += (v[j][0] * v[j][0] + v[j][1] * v[j][1]) + (v[j][2] * v[j][2] + v[j][3] * v[j][3]); }
            s = wave_sum(s);
            u32x2* o = (u32x2*)(hb + (size_t)row * 1024) + lane;
#pragma unroll
            for (int j = 0; j < 4; ++j) { u32x2 w; w.x = pk2(v[j][0], v[j][1]); w.y = pk2(v[j][2], v[j][3]); o[64 * j] = w; }
            if (lane < 16) ssq[(size_t)row * 16 + lane] = lane == 0 ? s : 0.f;
        }
    }
    SEAM(0);
    if (IN(1)) {
        s5_expand(ws, gtid, NGT);
        skinny16(hb, (const bf16_t*)(ws + WS_W0DT), ssq, (float*)(ws + WS_DT), gw, NGW, lane);
        OrdStd S; S.init(hb, ws + WS_W0IN, 1024, 1024, T, 3072, 1024, G, bx);
        const GDesc gd{1024, 1024, 128L * 1024 * 2, 128L * 1024 * 2};
        EpiIn0 E{ssq, (bf16_t*)(ws + WS_UPERM), (bf16_t*)(ws + WS_ZS), (bf16_t*)(ws + WS_XBC)};
        gemm_phase<EpiIn0, OrdStd, true>(lds, gd, S, E);
    }
    SEAM(1);
    if (IN(2)) {
        if (bx < 32) {
            OrdS5A S{(const char*)(ws + WS_UPERM), (const char*)(ws + WS_S5W1), bx};
            const GDesc gd{1152, 1024, 128L * 1152 * 2, 0};
            EpiS5A E{(bf16_t*)(ws + WS_UPERM), (const float*)(ws + WS_A64)};
            gemm_phase<EpiS5A, OrdS5A, false>(lds, gd, S, E);
        } else if (bx < 160) {
            const int w = bx - 32, item = ((((w & 7) * 4 + (w >> 5)) << 2) | ((w >> 3) & 3)), h = item & 15;
            ssd_item(lds, ws, args.in[15], args.in[16], args.in[17][h], -expf(args.in[18][h]), args.in[19][h], item, wave, lane);
        } else {
            LAS float* scr = (LAS float*)(lds + wave * 16384); const int gw2 = (bx - 160) * NWAVES + wave, ngw2 = (G - 160) * NWAVES;
            { FOut0 f{args.in[21], args.in[20]}; transpose_all(f, (bf16_t*)(ws + WS_W0OUT), 1536, 1024, scr, lane, gw2, ngw2); }
            { FGu f{args.in[28], args.in[29], args.in[2]}; transpose_all(f, (bf16_t*)(ws + WS_W0GU), 1024, 5632, scr, lane, gw2, ngw2); }
            { FPlain f{args.in[30], 1024}; transpose_all(f, (bf16_t*)(ws + WS_W0DN), FFH, 1024, scr, lane, gw2, ngw2); }
        }
    }
    SEAM(2);
    if (IN(3)) {
        if (bx < 128) {
            OrdS5C S{(const char*)(ws + WS_UPERM), (const char*)(ws + WS_S5BC), bx};
            const GDesc gd{1152, 1536, 128L * 1152 * 2, 128L * 1536 * 2};
            EpiS5C E{(bf16_t*)(ws + WS_ZG)};
            gemm_phase<EpiS5C, OrdS5C, false>(lds, gd, S, E);
        } else {
            bf16_t* yab = (bf16_t*)(ws + WS_YAB); const float* ssqb = (const float*)(ws + WS_SSQB);
            for (int row = (bx - 128) * NWAVES + wave; row < T; row += (G - 128) * NWAVES) {
                const f32x4* sp = (const f32x4*)(ssqb + (size_t)row * 32); float sacc = 0.f;
#pragma unroll
                for (int j = 0; j < 8; ++j) { const f32x4 v = sp[j]; sacc += (v[0] + v[1]) + (v[2] + v[3]); }
                const float rs = rsqrtf(sacc * (1.0f / 1024.0f) + EPS);
                u32x2* p = (u32x2*)(yab + (size_t)row * 1536) + lane;
#pragma unroll
                for (int j = 0; j < 4; ++j) { u32x2 w = p[64 * j]; w.x = pk2(bflo(w.x) * rs, bfhi(w.x) * rs); w.y = pk2(bflo(w.y) * rs, bfhi(w.y) * rs); p[64 * j] = w; }
            }
        }
    }
    SEAM(3);
    if (IN(4)) {
        if (bx < 128) {
            OrdStd S; S.init(ws + WS_ZG, ws + WS_W0GLU, 512, 512, T, 512, 512, 128, bx);
            const GDesc gd{512, 512, 128L * 512 * 2, 128L * 512 * 2};
            EpiGlu E{(const bf16_t*)(ws + WS_ZG), args.in[14], (bf16_t*)(ws + WS_YAB)};
            gemm_phase<EpiGlu, OrdStd, false>(lds, gd, S, E);
        } else {
            LAS float* scr = (LAS float*)(lds + wave * 16384); const int gw2 = (bx - 128) * NWAVES + wave, ngw2 = (G - 128) * NWAVES;
            { FIn1 f{args.in[22], args.in[1] + 1024}; transpose_all(f, (bf16_t*)(ws + WS_W1IN), 1024, 4096, scr, lane, gw2, ngw2); }
            { FAlr f{args.in[22], args.in[1] + 1024}; transpose_all(f, (bf16_t*)(ws + WS_W1ALR), 1024, 32, scr, lane, gw2, ngw2); }
            { FGate f{args.in[22], args.in[1] + 1024}; transpose_all(f, (bf16_t*)(ws + WS_W1GT), 1024, 2048, scr, lane, gw2, ngw2); }
            { FOut1 f{args.in[27], args.in[23], args.in[26]}; transpose_all(f, (bf16_t*)(ws + WS_W1OUT), 2048, 1024, scr, lane, gw2, ngw2); }
            { FGu f{args.in[28] + (size_t)1024 * FFH, args.in[29] + (size_t)1024 * FFH, args.in[2] + 1024}; transpose_all(f, (bf16_t*)(ws + WS_W1GU), 1024, 5632, scr, lane, gw2, ngw2); }
            { FPlain f{args.in[30] + (size_t)FFH * 1024, 1024}; transpose_all(f, (bf16_t*)(ws + WS_W1DN), FFH, 1024, scr, lane, gw2, ngw2); }
        }
    }
    SEAM(4);
    if (IN(5)) {
        OrdStd S; S.init(ws + WS_YAB, ws + WS_W0OUT, 1536, 1536, T, 1024, 1536, G, bx);
        const GDesc gd{1536, 1536, 128L * 1536 * 2, 128L * 1536 * 2};
        EpiRes E{args.in[0], hres, hb, ssq};
        gemm_phase<EpiRes, OrdStd, true>(lds, gd, S, E);
    }
    SEAM(5);
    if (IN(6)) {
        OrdStd S; S.init(hb, ws + WS_W0GU, 1024, 1024, T, 5632, 1024, G, bx);
        const GDesc gd{1024, 1024, 128L * 1024 * 2, 128L * 1024 * 2};
        EpiGu E{ssq, (bf16_t*)(ws + WS_HID0)};
        gemm_phase<EpiGu, OrdStd, true>(lds, gd, S, E);
    }
    SEAM(6);
    if (IN(7)) {
        OrdStd S; S.init(ws + WS_HID0, ws + WS_W0DN, FFH, FFH, T, 1024, FFH, G, bx);
        const GDesc gd{FFH, FFH, 128L * FFH * 2, 128L * FFH * 2};
        EpiRes E{hres, hres, hb, ssq};
        gemm_phase<EpiRes, OrdStd, true>(lds, gd, S, E);
    }
    SEAM(7);
    if (IN(8)) {
        skinny_loga(hb, (const bf16_t*)(ws + WS_W1ALR), ssq, args.in[24], args.in[25], (bf16_t*)(ws + WS_LOGA), gw, NGW, lane);
        OrdStd S; S.init(hb, ws + WS_W1IN, 1024, 1024, T, 4096, 1024, G, bx);
        const GDesc gd{1024, 1024, 128L * 1024 * 2, 128L * 1024 * 2};
        EpiIn1 E{ssq, (const float*)(ws + WS_ROT), (bf16_t*)(ws + WS_QKV)};
        gemm_phase<EpiIn1, OrdStd, true>(lds, gd, S, E);
    }
    SEAM(8);
    if (IN(9)) {
        for (int w = bx; w < 256; w += G) { const int item = (((w & 7) * 8 + (w >> 5)) << 2) | ((w >> 3) & 3); mix1_item(lds, ws, item, wave, lane); }
    }
    SEAM(9);
    if (IN(10)) {
        bf16_t* qkv = (bf16_t*)(ws + WS_QKV);
        for (int task = gw; task < T * 8; task += NGW) {
            const int row = task >> 3, hs = task & 7;
            u32x2* p = (u32x2*)(qkv + (size_t)row * 4096 + 2048 + hs * 256) + lane;
            const u32x2 w = *p; const float v0 = bflo(w.x), v1 = bfhi(w.x), v2 = bflo(w.y), v3 = bfhi(w.y);
            const float s1 = wave_sum((v0 + v1) + (v2 + v3)), s2 = wave_sum((v0 * v0 + v1 * v1) + (v2 * v2 + v3 * v3));
            float mu = 0.f, rs;
            if (hs < 4) { mu = s1 * (1.f / 256.f); const float var = fmaxf(s2 * (1.f / 256.f) - mu * mu, 0.f); rs = rsqrtf(var + EPS); }
            else rs = rsqrtf(s2 * (1.f / 256.f) + EPS);
            u32x2 o; o.x = pk2((v0 - mu) * rs, (v1 - mu) * rs); o.y = pk2((v2 - mu) * rs, (v3 - mu) * rs); *p = o;
        }
    }
    SEAM(10);
    if (IN(11)) {
        OrdStd S; S.init(hb, ws + WS_W1GT, 1024, 1024, T, 2048, 1024, G, bx);
        const GDesc gd{1024, 1024, 128L * 1024 * 2, 128L * 1024 * 2};
        EpiGate E{ssq, (bf16_t*)(ws + WS_QKV)};
        gemm_phase<EpiGate, OrdStd, true>(lds, gd, S, E);
    }
    SEAM(11);
    if (IN(12)) {
        OrdStd S; S.init(ws + WS_QKV + 2048 * 2, ws + WS_W1OUT, 4096, 2048, T, 1024, 2048, G, bx);
        const GDesc gd{4096, 2048, 128L * 4096 * 2, 128L * 2048 * 2};
        EpiRes E{hres, hres, hb, ssq};
        gemm_phase<EpiRes, OrdStd, true>(lds, gd, S, E);
    }
    SEAM(12);
    if (IN(13)) {
        OrdStd S; S.init(hb, ws + WS_W1GU, 1024, 1024, T, 5632, 1024, G, bx);
        const GDesc gd{1024, 1024, 128L * 1024 * 2, 128L * 1024 * 2};
        EpiGu E{ssq, (bf16_t*)(ws + WS_HID1)};
        gemm_phase<EpiGu, OrdStd, true>(lds, gd, S, E);
    }
    SEAM(13);
    if (IN(14)) {
        OrdStd S; S.init(ws + WS_HID1, ws + WS_W1DN, FFH, FFH, T, 1024, FFH, G, bx);
        const GDesc gd{FFH, FFH, 128L * FFH * 2, 128L * FFH * 2};
        EpiRes E{hres, hres, hb, ssq};
        gemm_phase<EpiRes, OrdStd, true>(lds, gd, S, E);
    }
    SEAM(14);
    if (IN(15)) {
        const float* fg = args.in[3];
        for (int row = gw; row < T; row += NGW) {
            const float rs = row_rstd(ssq, row);
            f32x4* p = (f32x4*)(hres + (size_t)row * 1024) + lane; const f32x4* gp = (const f32x4*)fg + lane;
#pragma unroll
            for (int j = 0; j < 4; ++j) p[64 * j] = p[64 * j] * rs * gp[64 * j];
        }
    }
#undef IN
#undef SEAM
}

extern "C" void kernel_launch(void* const* d_in, const int* in_sizes, int n_in, void* d_out, int out_size, void* d_ws, size_t ws_size, hipStream_t stream) {
    static int grid = 0;
    if (grid == 0) {
        if (n_in != 31 || out_size != T * DM || ws_size < WS_END) { fprintf(stderr, "kernel_launch: unexpected problem (n_in %d, out %d, ws %zu)\n", n_in, out_size, ws_size); grid = -1; return; }
        int dev = 0, cus = 0, per_cu = 0;
        if (hipGetDevice(&dev) != hipSuccess || hipDeviceGetAttribute(&cus, hipDeviceAttributeMultiprocessorCount, dev) != hipSuccess) { grid = -1; return; }
        if (hipFuncSetAttribute((const void*)mega_fwd, hipFuncAttributeMaxDynamicSharedMemorySize, LDS_BYTES) != hipSuccess) { fprintf(stderr, "kernel_launch: hipFuncSetAttribute failed\n"); grid = -1; return; }
        if (hipOccupancyMaxActiveBlocksPerMultiprocessor(&per_cu, (const void*)mega_fwd, NTHREADS, LDS_BYTES) != hipSuccess || per_cu < 1) { fprintf(stderr, "kernel_launch: occupancy query says %d blocks per CU\n", per_cu); grid = -1; (void)hipGetLastError(); return; }
        grid = cus;
    }
    if (grid < 0) return;
    (void)hipMemsetAsync((char*)d_ws + WS_CTL, 0, CTL_ZERO_BYTES, stream);
    Args a{};
    for (int i = 0; i < 31; ++i) a.in[i] = (const float*)d_in[i];
    a.out = (float*)d_out; a.ws = (unsigned char*)d_ws;
#if MK_PER_PHASE
    for (int p = 0; p < NPH; ++p) { a.ph_lo = p; a.ph_hi = p + 1; hipLaunchKernelGGL(mega_fwd, dim3(grid), dim3(NTHREADS), LDS_BYTES, stream, a); }
#else
    a.ph_lo = 0; a.ph_hi = NPH;
    void* kargs[] = {&a};
    hipError_t e = hipLaunchCooperativeKernel((const void*)mega_fwd, dim3(grid), dim3(NTHREADS), kargs, LDS_BYTES, stream);
    if (e != hipSuccess) fprintf(stderr, "kernel_launch: cooperative launch failed: %s (grid %d)\n", hipGetErrorString(e), grid);
#endif
}
```

```cpp
#include <hip/hip_runtime.h>
#include <cstdio>
#include <cstdint>

#ifndef MK_PER_PHASE
#define MK_PER_PHASE 0
#endif

#define GAS __attribute__((address_space(1)))
#define LAS __attribute__((address_space(3)))
typedef unsigned short bf16_t;
typedef short bf16x8 __attribute__((ext_vector_type(8)));
typedef float f32x4 __attribute__((ext_vector_type(4)));
typedef float f32x2 __attribute__((ext_vector_type(2)));
typedef unsigned u32x4 __attribute__((ext_vector_type(4)));
typedef unsigned u32x2 __attribute__((ext_vector_type(2)));

constexpr int NB = 8, SEQ = 2048, DM = 1024, T = NB * SEQ;
constexpr int EVEN_IN = 3088, ODD_IN = 6160, FFH = 2816;
constexpr float EPS = 1e-6f;
constexpr int NWAVES = 8, NTHREADS = 512;

constexpr size_t MiB = 1u << 20;
constexpr size_t WS_CTL = 0, CTL_ZERO_BYTES = 65536;
constexpr size_t WS_SSQ = 1 * MiB;
constexpr size_t WS_SSQB = 2 * MiB;
constexpr size_t WS_DT = 4 * MiB;
constexpr size_t WS_ROT = 5 * MiB;
constexpr size_t WS_A64 = 6 * MiB;
constexpr size_t WS_HB = 7 * MiB;
constexpr size_t WS_W0IN = 39 * MiB;
constexpr size_t WS_W0DT = 45 * MiB;
constexpr size_t WS_W0GLU = 45 * MiB + 512 * 1024;
constexpr size_t WS_W0OUT = 46 * MiB;
constexpr size_t WS_W0GU = 49 * MiB;
constexpr size_t WS_W0DN = 60 * MiB;
constexpr size_t WS_S5BC = 66 * MiB;
constexpr size_t WS_S5W1 = 90 * MiB;
constexpr size_t WS_UPERM = 98 * MiB;
constexpr size_t WS_ZS = 116 * MiB;
constexpr size_t WS_XBC = 148 * MiB;
constexpr size_t WS_YAB = 196 * MiB;
constexpr size_t WS_S5K = 244 * MiB;
constexpr size_t WS_ZG = WS_HB;
constexpr size_t WS_HID0 = 148 * MiB;
constexpr size_t WS_W1IN = 66 * MiB;
constexpr size_t WS_W1ALR = 74 * MiB;
constexpr size_t WS_W1GT = 74 * MiB + 512 * 1024;
constexpr size_t WS_W1OUT = 79 * MiB;
constexpr size_t WS_W1GU = 83 * MiB;
constexpr size_t WS_W1DN = 94 * MiB;
constexpr size_t WS_QKV = 100 * MiB;
constexpr size_t WS_HID1 = 100 * MiB;
constexpr size_t WS_LOGA = 39 * MiB;
constexpr size_t WS_SLOC = 228 * MiB;
constexpr size_t WS_LTOT = 241 * MiB;
constexpr size_t WS_END = 256 * MiB;

constexpr int CW_BAR = 4096;


typedef __bf16 bf16v2 __attribute__((ext_vector_type(2)));
__device__ __forceinline__ unsigned cvt_pk_bf16(float lo, float hi) { const f32x2 v = {lo, hi}; const bf16v2 r = __builtin_convertvector(v, bf16v2); return __builtin_bit_cast(unsigned, r); }
__device__ __forceinline__ unsigned f2bf(float f) { const __bf16 r = (__bf16)f; return (unsigned)__builtin_bit_cast(unsigned short, r); }
__device__ __forceinline__ unsigned pk2(float lo, float hi) { return cvt_pk_bf16(lo, hi); }
__device__ __forceinline__ float bf2f(unsigned h) { return __uint_as_float(h << 16); }
__device__ __forceinline__ float bflo(unsigned w) { return __uint_as_float(w << 16); }
__device__ __forceinline__ float bfhi(unsigned w) { return __uint_as_float(w & 0xffff0000u); }

__device__ __forceinline__ float wave_sum(float v) {
#pragma unroll
    for (int o = 1; o < 64; o <<= 1) v += __shfl_xor(v, o);
    return v;
}
__device__ __forceinline__ float sigmoidf_(float x) { return __builtin_amdgcn_rcpf(1.0f + __expf(-x)); }
__device__ __forceinline__ float siluf_(float x) { return x * __builtin_amdgcn_rcpf(1.0f + __expf(-x)); }
__device__ __forceinline__ float gelu_tanh(float x) { const float u = 1.5957691216f * (x + 0.044715f * x * x * x); return x * __builtin_amdgcn_rcpf(1.0f + __expf(-u)); }
__device__ __forceinline__ float ld_coh(const float* p) { return __hip_atomic_load(p, __ATOMIC_RELAXED, __HIP_MEMORY_SCOPE_AGENT); }
#define LDS_WAIT() asm volatile("s_waitcnt lgkmcnt(0)" ::: "memory")
#define VM_WAIT() asm volatile("s_waitcnt vmcnt(0)" ::: "memory")

__device__ __forceinline__ float row_rstd(const float* ssq, int row) {
    const f32x4* p = (const f32x4*)(ssq + (size_t)row * 16);
    const f32x4 a = p[0], b = p[1], c = p[2], d = p[3];
    const float s = ((a.x + a.y) + (a.z + a.w)) + ((b.x + b.y) + (b.z + b.w)) + ((c.x + c.y) + (c.z + c.w)) + ((d.x + d.y) + (d.z + d.w));
    return rsqrtf(s * (1.0f / 1024.0f) + EPS);
}

constexpr int BM = 256, BK = 64, HALF = 128, HTB = HALF * BK * 2, STAGE_BYTES = 8 * HTB;
__device__ __forceinline__ int lds_byte(int r, int c) { const int st = (r >> 4) * 2 + (c >> 5), rr = r & 15, cc = c & 31, ob = rr * 64 + cc * 2; return st * 1024 + (ob ^ (((ob >> 9) & 1) << 5)); }
__device__ __forceinline__ void stage_rc(int b, int& R, int& C) { const int st = b / 1024, sb = b % 1024, swz = sb ^ (((sb >> 9) & 1) << 5); R = (st >> 1) * 16 + swz / 64; C = (st & 1) * 32 + (swz % 64) / 2; }
__device__ __forceinline__ int perm32(int rho) { const int n = rho >> 4, i = rho & 15; return 8 * (i >> 2) + 4 * n + (i & 3); }

struct Unit { const char* a; const char* b; long bjump; int pm, pn, nt, aux; };
struct GDesc { int lda, ldb; long hsA, hsB; };

struct OrdStd {
    const char* A; const char* B; int lda, ldb, nM, nN, nwg, G, c, nt;
    __device__ void init(const void* A_, const void* B_, int lda_, int ldb_, int M, int N, int K, int G_, int c_) { A = (const char*)A_; B = (const char*)B_; lda = lda_; ldb = ldb_; nM = M / BM; nN = N / BM; nwg = nM * nN; G = G_; c = c_; nt = K / BK; }
    __device__ bool next(int i, Unit& u) const {
        const long L = (long)i * G + c; if (c < 0 || L >= nwg) return false;
        int wgid = (int)L; { const int q = nwg / 8, r = nwg % 8, xcd = wgid % 8, off = wgid / 8; wgid = (xcd < r ? xcd * (q + 1) : r * (q + 1) + (xcd - r) * q) + off; }
        const int nig = 8 * nN, gid = wgid / nig, fm = gid * 8, gsz = (nM - fm) < 8 ? (nM - fm) : 8;
        u.pm = fm + ((wgid % nig) % gsz); u.pn = (wgid % nig) / gsz; u.nt = nt; u.bjump = 0; u.aux = 0;
        u.a = A + (size_t)u.pm * BM * lda * 2; u.b = B + (size_t)u.pn * BM * ldb * 2; return true;
    }
    __device__ __forceinline__ void a_ready(const Unit&) const {}
    __device__ __forceinline__ void done(const Unit&) const {}
};

template <class Epi, class Sched, bool ALIGN_EPI>
__device__ __forceinline__ void gemm_phase(LAS unsigned char* lds, const GDesc g, const Sched& S, const Epi& E) {
    const int tid = threadIdx.x, wid = __builtin_amdgcn_readfirstlane(tid >> 6), lane = tid & 63, wr = wid >> 2, wc = wid & 3, fr = lane & 15, fq = lane >> 4;
    unsigned voffA[2], voffB[2];
#pragma unroll
    for (int i = 0; i < 2; ++i) { int R, C; stage_rc(tid * 16 + i * 8192, R, C); const int Rb = Epi::PERM ? ((R & ~31) + perm32(R & 31)) : R;
        voffA[i] = (unsigned)(R * g.lda + C) * 2u; voffB[i] = (unsigned)(Rb * g.ldb + C) * 2u; }
    const long kstep = BK * 2;
    const long hsA = g.hsA, hsB = g.hsB;
    const unsigned ldsw = (unsigned)wid * 1024u;
    const int aoff = lds_byte(wr * 64 + fr, fq * 8), boff = lds_byte(wc * 32 + fr, fq * 8);
#define PG8_SA(b, h) (((b) * 2 + (h)) * HTB)
#define PG8_SB(b, h) ((4 + (b) * 2 + (h)) * HTB)
#define PG8_STAGE(bufoff, gbase, voff) do { _Pragma("unroll") for (int _i = 0; _i < 2; ++_i) \
        __builtin_amdgcn_global_load_lds((const unsigned*)((const char*)(gbase) + (voff)[_i]), (LAS unsigned*)(lds + (bufoff) + ldsw + _i * 8192), 16, 0, 0); } while (0)
#define PG8_LDA(dst, b, h) do { _Pragma("unroll") for (int m = 0; m < 4; ++m) _Pragma("unroll") for (int k = 0; k < 2; ++k) dst[m][k] = *(const LAS bf16x8*)(lds + PG8_SA(b, h) + aoff + m * 2048 + k * 1024); } while (0)
#define PG8_LDB(dst, b, h) do { _Pragma("unroll") for (int n = 0; n < 2; ++n) _Pragma("unroll") for (int k = 0; k < 2; ++k) dst[n][k] = *(const LAS bf16x8*)(lds + PG8_SB(b, h) + boff + n * 2048 + k * 1024); } while (0)
#define PG8_MMA(ai, bj, At, Bt) do { __builtin_amdgcn_s_setprio(1); _Pragma("unroll") for (int m = 0; m < 4; ++m) _Pragma("unroll") for (int n = 0; n < 2; ++n) _Pragma("unroll") for (int k = 0; k < 2; ++k) \
        acc[ai][bj][m][n] = __builtin_amdgcn_mfma_f32_16x16x32_bf16(Bt[n][k], At[m][k], acc[ai][bj][m][n], 0, 0, 0); __builtin_amdgcn_s_setprio(0); } while (0)
#define PG8_WAIT_V(n) asm volatile("s_waitcnt vmcnt(" #n ")" ::: "memory")
#define PG8_WAIT_L(n) asm volatile("s_waitcnt lgkmcnt(" #n ")" ::: "memory")
#define PG8_BAR __builtin_amdgcn_s_barrier()
#define PG8_SCHED __builtin_amdgcn_sched_barrier(0)
    Unit cur, nxt; int ui = 0;
    if (!S.next(0, cur)) return;
    f32x4 acc[2][2][4][2];
#pragma unroll
    for (int a = 0; a < 2; ++a)
#pragma unroll
        for (int b = 0; b < 2; ++b)
#pragma unroll
            for (int m = 0; m < 4; ++m)
#pragma unroll
                for (int n = 0; n < 2; ++n) acc[a][b][m][n] = (f32x4){0.f, 0.f, 0.f, 0.f};
    bf16x8 At[4][2], B0[2][2], B1[2][2];
    const char* cA = cur.a; const char* cB = cur.b;
    S.a_ready(cur);
    PG8_STAGE(PG8_SB(0, 0), cB, voffB); PG8_STAGE(PG8_SB(0, 1), cB + hsB, voffB); PG8_STAGE(PG8_SA(0, 0), cA, voffA); PG8_STAGE(PG8_SA(0, 1), cA + hsA, voffA);
    if (wr == 1) PG8_BAR;
    PG8_WAIT_V(2); PG8_BAR;
    PG8_STAGE(PG8_SB(1, 0), cB + kstep, voffB); PG8_STAGE(PG8_SA(1, 0), cA + kstep, voffA); PG8_STAGE(PG8_SB(1, 1), cB + hsB + kstep, voffB);
    PG8_WAIT_V(6); PG8_BAR;
    for (;;) {
        const bool has_next = S.next(ui + 1, nxt);
        const char* nA = has_next ? nxt.a : cA; const char* nB = has_next ? nxt.b : cB;
        const int nt = cur.nt; const long bjump = cur.bjump;
        for (int t = 0; t < nt; t += 2) {
            const bool last = (t == nt - 2);
            const char* a1 = cA + (size_t)(t + 1) * kstep;
            const char* a2 = last ? nA : cA + (size_t)(t + 2) * kstep; const char* b2 = last ? nB : cB + (size_t)(t + 2) * kstep + bjump;
            const char* a3 = a2 + kstep; const char* b3 = b2 + kstep;
            if (last && has_next) S.a_ready(nxt);
            PG8_LDB(B0, 0, 0); PG8_LDB(B1, 0, 1); PG8_SCHED; PG8_LDA(At, 0, 0); PG8_STAGE(PG8_SA(1, 1), a1 + hsA, voffA);
            PG8_WAIT_V(8); PG8_WAIT_L(0); PG8_BAR; PG8_MMA(0, 0, At, B0); PG8_MMA(0, 1, At, B1); PG8_BAR; PG8_SCHED;
            PG8_LDA(At, 0, 1); PG8_STAGE(PG8_SB(0, 0), b2, voffB); PG8_STAGE(PG8_SB(0, 1), b2 + hsB, voffB); PG8_STAGE(PG8_SA(0, 0), a2, voffA);
            PG8_WAIT_V(8); PG8_WAIT_L(0); PG8_BAR; PG8_MMA(1, 0, At, B0); PG8_MMA(1, 1, At, B1); PG8_BAR; PG8_SCHED;
            PG8_LDB(B0, 1, 0); PG8_LDB(B1, 1, 1); PG8_SCHED; PG8_LDA(At, 1, 0); PG8_STAGE(PG8_SA(0, 1), a2 + hsA, voffA);
            PG8_WAIT_V(8); PG8_WAIT_L(0); PG8_BAR; PG8_MMA(0, 0, At, B0); PG8_MMA(0, 1, At, B1); PG8_BAR; PG8_SCHED;
            PG8_LDA(At, 1, 1); PG8_STAGE(PG8_SB(1, 0), b3, voffB); PG8_STAGE(PG8_SB(1, 1), b3 + hsB, voffB); PG8_STAGE(PG8_SA(1, 0), a3, voffA);
            PG8_WAIT_V(8); PG8_WAIT_L(0); PG8_BAR; PG8_MMA(1, 0, At, B0); PG8_MMA(1, 1, At, B1); PG8_BAR; PG8_SCHED;
        }
        if constexpr (ALIGN_EPI) { if (wr == 0) PG8_BAR; }
        if constexpr (!Epi::AFTER_DRAIN) { E(acc, cur, wr, wc, fr, fq); S.done(cur); }
        if (!has_next) break;
#pragma unroll
        for (int a = 0; a < 2; ++a)
#pragma unroll
            for (int b = 0; b < 2; ++b)
#pragma unroll
                for (int m = 0; m < 4; ++m)
#pragma unroll
                    for (int n = 0; n < 2; ++n) acc[a][b][m][n] = (f32x4){0.f, 0.f, 0.f, 0.f};
        cur = nxt; cA = nA; cB = nB; ++ui;
        if constexpr (ALIGN_EPI) { if (wr == 1) PG8_BAR; }
    }
    PG8_WAIT_V(0);
    if constexpr (!ALIGN_EPI) { if (wr == 0) PG8_BAR; }
    PG8_BAR;
    if constexpr (Epi::AFTER_DRAIN) { E.fused(acc, cur, wr, wc, fr, fq, lds, wid, lane); S.done(cur); }
#undef PG8_SA
#undef PG8_SB
#undef PG8_STAGE
#undef PG8_LDA
#undef PG8_LDB
#undef PG8_MMA
#undef PG8_WAIT_V
#undef PG8_WAIT_L
#undef PG8_BAR
#undef PG8_SCHED
}

__device__ __forceinline__ u32x4 pack8(const f32x4 v0, const f32x4 v1) { u32x4 w; w.x = cvt_pk_bf16(v0[0], v0[1]); w.y = cvt_pk_bf16(v0[2], v0[3]); w.z = cvt_pk_bf16(v1[0], v1[1]); w.w = cvt_pk_bf16(v1[2], v1[3]); return w; }

struct EpiIn0 {
    static constexpr bool PERM = true, AFTER_DRAIN = false;
    const float* ssq; bf16_t* uperm; bf16_t* zs; bf16_t* xbc;
    __device__ __forceinline__ void operator()(const f32x4 (&acc)[2][2][4][2], const Unit& u, int wr, int wc, int fr, int fq) const {
#pragma unroll
        for (int ai = 0; ai < 2; ++ai)
#pragma unroll
            for (int m = 0; m < 4; ++m) {
                const int row = u.pm * BM + ai * HALF + wr * 64 + m * 16 + fr; const float rs = row_rstd(ssq, row);
#pragma unroll
                for (int bj = 0; bj < 2; ++bj) {
                    const int c = u.pn * BM + bj * HALF + wc * 32 + 8 * fq;
                    const u32x4 w = pack8(acc[ai][bj][m][0] * rs, acc[ai][bj][m][1] * rs);
                    bf16_t* dst;
                    if (u.pn < 2) { const int g = c >> 4, m0 = c & 15; dst = uperm + ((size_t)(g * 256 + (row >> 6)) * 1152 + 128 + (row & 63) * 16 + m0); }
                    else if (u.pn < 6) dst = zs + (size_t)row * 1024 + (c - 512);
                    else dst = xbc + (size_t)row * 1536 + (c - 1536);
                    *(u32x4*)dst = w;
                }
            }
    }
};
struct EpiS5A {
    static constexpr bool PERM = false, AFTER_DRAIN = true;
    bf16_t* uperm; const float* a64;
    __device__ __forceinline__ void operator()(const f32x4 (&)[2][2][4][2], const Unit&, int, int, int, int) const {}
    __device__ __forceinline__ void fused(f32x4 (&acc)[2][2][4][2], const Unit& u, int wr, int wc, int fr, int fq, LAS unsigned char* lds, int wid, int lane) const {
        LAS float* S = (LAS float*)lds;
#pragma unroll
        for (int ai = 0; ai < 2; ++ai)
#pragma unroll
            for (int m = 0; m < 4; ++m) { const int r = ai * HALF + wr * 64 + m * 16 + fr;
#pragma unroll
                for (int n = 0; n < 2; ++n) *(LAS f32x4*)(S + r * 128 + wc * 32 + n * 16 + 4 * fq) = acc[ai][0][m][n]; }
        LDS_WAIT(); __syncthreads();
        const int g = u.aux, tid = wid * 64 + lane, b = tid >> 6, p = tid & 63;
        const f32x2 a = *(const f32x2*)(a64 + (size_t)(g * 64 + p) * 2);
        float xr = 0.f, xi = 0.f;
        for (int c = 0; c < 32; ++c) {
            const int r = b * 32 + c;
            bf16_t* dst = uperm + (size_t)(g * 256 + r) * 1152;
            dst[p] = (bf16_t)f2bf(xr); dst[64 + p] = (bf16_t)f2bf(xi);
            const float sr = S[r * 128 + p], si = S[r * 128 + 64 + p];
            const float nr = a.x * xr - a.y * xi + sr, ni = a.x * xi + a.y * xr + si;
            xr = nr; xi = ni;
        }
        __syncthreads();
    }
};
struct EpiS5C {
    static constexpr bool PERM = true, AFTER_DRAIN = false;
    bf16_t* zg;
    __device__ __forceinline__ void operator()(const f32x4 (&acc)[2][2][4][2], const Unit& u, int wr, int wc, int fr, int fq) const {
        const int g = u.aux >> 2, i = u.aux & 3;
#pragma unroll
        for (int ai = 0; ai < 2; ++ai)
#pragma unroll
            for (int m = 0; m < 4; ++m) {
                const int r = ai * HALF + wr * 64 + m * 16 + fr;
#pragma unroll
                for (int bj = 0; bj < 2; ++bj) {
                    const int ct = bj * HALF + wc * 32 + 8 * fq, tp = ct >> 4, n0 = ct & 15;
                    f32x4 v0 = acc[ai][bj][m][0], v1 = acc[ai][bj][m][1];
#pragma unroll
                    for (int j = 0; j < 4; ++j) { v0[j] = gelu_tanh(v0[j]); v1[j] = gelu_tanh(v1[j]); }
                    *(u32x4*)(zg + ((size_t)(r * 64 + 16 * i + tp) * 512 + g * 16 + n0)) = pack8(v0, v1);
                }
            }
    }
};
struct EpiGlu {
    static constexpr bool PERM = true, AFTER_DRAIN = false;
    const bf16_t* zg; const float* bias; bf16_t* yab;
    __device__ __forceinline__ void operator()(const f32x4 (&acc)[2][2][4][2], const Unit& u, int wr, int wc, int fr, int fq) const {
#pragma unroll
        for (int bj = 0; bj < 2; ++bj) {
            const int c = u.pn * BM + bj * HALF + wc * 32 + 8 * fq;
            const f32x4 b0 = *(const f32x4*)(bias + c), b1 = *(const f32x4*)(bias + c + 4);
#pragma unroll
            for (int ai = 0; ai < 2; ++ai)
#pragma unroll
                for (int m = 0; m < 4; ++m) {
                    const int row = u.pm * BM + ai * HALF + wr * 64 + m * 16 + fr;
                    const u32x4 zw = *(const u32x4*)(zg + (size_t)row * 512 + c);
                    f32x4 v0 = acc[ai][bj][m][0] + b0, v1 = acc[ai][bj][m][1] + b1;
                    v0[0] = bflo(zw.x) * sigmoidf_(v0[0]); v0[1] = bfhi(zw.x) * sigmoidf_(v0[1]); v0[2] = bflo(zw.y) * sigmoidf_(v0[2]); v0[3] = bfhi(zw.y) * sigmoidf_(v0[3]);
                    v1[0] = bflo(zw.z) * sigmoidf_(v1[0]); v1[1] = bfhi(zw.z) * sigmoidf_(v1[1]); v1[2] = bflo(zw.w) * sigmoidf_(v1[2]); v1[3] = bfhi(zw.w) * sigmoidf_(v1[3]);
                    *(u32x4*)(yab + (size_t)row * 1536 + 1024 + c) = pack8(v0, v1);
                }
        }
    }
};
template <int MODE>
struct EpiRes {
    static constexpr bool PERM = false, AFTER_DRAIN = false;
    const float* hin; float* hout; bf16_t* hb; float* ssq;
    __device__ __forceinline__ void operator()(const f32x4 (&acc)[2][2][4][2], const Unit& u, int wr, int wc, int fr, int fq) const {
#pragma unroll
        for (int ai = 0; ai < 2; ++ai)
#pragma unroll
            for (int m = 0; m < 4; ++m) {
                const int row = u.pm * BM + ai * HALF + wr * 64 + m * 16 + fr; float ss = 0.f;
#pragma unroll
                for (int bj = 0; bj < 2; ++bj)
#pragma unroll
                    for (int n = 0; n < 2; ++n) {
                        const size_t off = (size_t)row * 1024 + u.pn * BM + bj * HALF + wc * 32 + n * 16 + 4 * fq;
                        f32x4 h;
                        if (MODE == 0) h = *(const f32x4*)(hin + off) + acc[ai][bj][m][n];
                        else { const u32x2 w = *(const u32x2*)(hb + off); h = (f32x4){bflo(w.x), bfhi(w.x), bflo(w.y), bfhi(w.y)} + acc[ai][bj][m][n]; }
                        if (MODE == 2) *(f32x4*)(hout + off) = h;
                        else { u32x2 w; w.x = cvt_pk_bf16(h[0], h[1]); w.y = cvt_pk_bf16(h[2], h[3]); *(u32x2*)(hb + off) = w; }
                        ss += (h[0] * h[0] + h[1] * h[1]) + (h[2] * h[2] + h[3] * h[3]);
                    }
                ss += __shfl_xor(ss, 16); ss += __shfl_xor(ss, 32);
                if (fq == 0) ssq[(size_t)row * 16 + u.pn * 4 + wc] = ss;
            }
    }
};
struct EpiGu {
    static constexpr bool PERM = true, AFTER_DRAIN = false;
    const float* ssq; bf16_t* hid;
    __device__ __forceinline__ void operator()(const f32x4 (&acc)[2][2][4][2], const Unit& u, int wr, int wc, int fr, int fq) const {
#pragma unroll
        for (int ai = 0; ai < 2; ++ai)
#pragma unroll
            for (int m = 0; m < 4; ++m) {
                const int row = u.pm * BM + ai * HALF + wr * 64 + m * 16 + fr; const float rs = row_rstd(ssq, row);
#pragma unroll
                for (int bj = 0; bj < 2; ++bj) {
                    const f32x4 gt = acc[ai][bj][m][0] * rs, up = acc[ai][bj][m][1] * rs;
                    u32x2 w; w.x = cvt_pk_bf16(siluf_(gt[0]) * up[0], siluf_(gt[1]) * up[1]); w.y = cvt_pk_bf16(siluf_(gt[2]) * up[2], siluf_(gt[3]) * up[3]);
                    *(u32x2*)(hid + (size_t)row * FFH + u.pn * 128 + bj * 64 + wc * 16 + 4 * fq) = w;
                }
            }
    }
};
struct EpiIn1 {
    static constexpr bool PERM = true, AFTER_DRAIN = false;
    const float* ssq; const float* rot; bf16_t* qkv;
    __device__ __forceinline__ void operator()(const f32x4 (&acc)[2][2][4][2], const Unit& u, int wr, int wc, int fr, int fq) const {
#pragma unroll
        for (int ai = 0; ai < 2; ++ai)
#pragma unroll
            for (int m = 0; m < 4; ++m) {
                const int row = u.pm * BM + ai * HALF + wr * 64 + m * 16 + fr; const float rs = row_rstd(ssq, row);
#pragma unroll
                for (int bj = 0; bj < 2; ++bj) {
                    const int c = u.pn * BM + bj * HALF + wc * 32 + 8 * fq;
                    f32x4 v0 = acc[ai][bj][m][0] * rs, v1 = acc[ai][bj][m][1] * rs;
                    if (u.pn < 4) {
                        const int i0 = (c & 127) >> 1; const float* cs = rot + ((size_t)(row & 2047) * 64 + i0) * 2;
                        const f32x4 c0 = *(const f32x4*)cs, c1 = *(const f32x4*)(cs + 4);
                        f32x4 o0, o1;
                        o0[0] = v0[0] * c0[0] - v0[1] * c0[1]; o0[1] = v0[0] * c0[1] + v0[1] * c0[0];
                        o0[2] = v0[2] * c0[2] - v0[3] * c0[3]; o0[3] = v0[2] * c0[3] + v0[3] * c0[2];
                        o1[0] = v1[0] * c1[0] - v1[1] * c1[1]; o1[1] = v1[0] * c1[1] + v1[1] * c1[0];
                        o1[2] = v1[2] * c1[2] - v1[3] * c1[3]; o1[3] = v1[2] * c1[3] + v1[3] * c1[2];
                        v0 = o0; v1 = o1;
                    }
                    *(u32x4*)(qkv + (size_t)row * 4096 + c) = pack8(v0, v1);
                }
            }
    }
};
struct EpiGate {
    static constexpr bool PERM = true, AFTER_DRAIN = false;
    const float* ssq; bf16_t* qkv;
    __device__ __forceinline__ void operator()(const f32x4 (&acc)[2][2][4][2], const Unit& u, int wr, int wc, int fr, int fq) const {
#pragma unroll
        for (int ai = 0; ai < 2; ++ai)
#pragma unroll
            for (int m = 0; m < 4; ++m) {
                const int row = u.pm * BM + ai * HALF + wr * 64 + m * 16 + fr; const float rs = row_rstd(ssq, row);
#pragma unroll
                for (int bj = 0; bj < 2; ++bj) {
                    const int c = u.pn * BM + bj * HALF + wc * 32 + 8 * fq;
                    bf16_t* p = qkv + (size_t)row * 4096 + 2048 + c;
                    const u32x4 ow = *(const u32x4*)p;
                    f32x4 v0 = acc[ai][bj][m][0] * rs, v1 = acc[ai][bj][m][1] * rs;
                    v0[0] = bflo(ow.x) * siluf_(v0[0]); v0[1] = bfhi(ow.x) * siluf_(v0[1]); v0[2] = bflo(ow.y) * siluf_(v0[2]); v0[3] = bfhi(ow.y) * siluf_(v0[3]);
                    v1[0] = bflo(ow.z) * siluf_(v1[0]); v1[1] = bfhi(ow.z) * siluf_(v1[1]); v1[2] = bflo(ow.w) * siluf_(v1[2]); v1[3] = bfhi(ow.w) * siluf_(v1[3]);
                    *(u32x4*)p = pack8(v0, v1);
                }
            }
    }
};

struct OrdS5A {
    const char* U; const char* W1; int c;
    __device__ bool next(int i, Unit& u) const {
        if (i != 0 || c < 0 || c >= 32) return false;
        u.pm = 0; u.pn = 0; u.nt = 16; u.bjump = 0; u.aux = c;
        u.a = U + ((size_t)c * 256 * 1152 + 128) * 2; u.b = W1 + (size_t)c * 128 * 1024 * 2; return true;
    }
    __device__ __forceinline__ void a_ready(const Unit&) const {}
    __device__ __forceinline__ void done(const Unit&) const {}
};
struct OrdS5C {
    const char* U; const char* BC; int c;
    __device__ bool next(int k, Unit& u) const {
        if (k != 0 || c < 0 || c >= 128) return false;
        const int g = c >> 2, i = 3 - (c & 3);
        u.pm = 0; u.pn = i; u.nt = 2 + 4 * (i + 1); u.bjump = -768L * (i + 1); u.aux = g * 4 + i;
        u.a = U + (size_t)g * 256 * 1152 * 2; u.b = BC + ((size_t)g * 256 * 1536 + 1024 + 128 * i) * 2; return true;
    }
    __device__ __forceinline__ void a_ready(const Unit&) const {}
    __device__ __forceinline__ void done(const Unit&) const {}
};

#define XB_TMO      128
#define XB_XCNT(j)  (256  + 64 * (j))
#define XB_XSUB(j)  (1280 + 64 * (j))
#define XB_XGEN(j)  (2304 + 64 * (j))
#define XB_TOP      3328
#define XB_TOPGEN   3392
#define XCD_BAR_WORDS 3456
#define XB_SPIN_CAP (1u << 18)
__device__ __forceinline__ unsigned xb_ld(unsigned* p)              { return __hip_atomic_load(p, __ATOMIC_RELAXED, __HIP_MEMORY_SCOPE_AGENT); }
__device__ __forceinline__ unsigned xb_add(unsigned* p, unsigned v) { return __hip_atomic_fetch_add(p, v, __ATOMIC_RELAXED, __HIP_MEMORY_SCOPE_AGENT); }
__device__ __forceinline__ unsigned xb_xcc_id() { return (unsigned)__builtin_amdgcn_s_getreg((3 << 11) | 20) & 0xFu; }
#define XB_SPIN(cond, bar) do { unsigned _sp = 0; while (cond) { __builtin_amdgcn_s_sleep(1); \
    if ((++_sp & 255u) == 0u) { if (xb_ld(&(bar)[XB_TMO])) break; if (_sp > XB_SPIN_CAP) { atomicAdd(&(bar)[XB_TMO], 1u); break; } } } } while (0)
struct XcdBarrier { unsigned* bar; unsigned x; volatile LAS unsigned* st; };
__device__ __forceinline__ XcdBarrier xcd_barrier_post(unsigned* bar, volatile LAS unsigned* st) {
    XcdBarrier b; b.bar = bar; b.x = xb_xcc_id(); b.st = st;
    if (threadIdx.x == 0) (void)xb_add(&bar[XB_XCNT(b.x)], 1u);
    return b;
}
__device__ __forceinline__ void xcd_barrier_complete(unsigned* bar, unsigned x, unsigned& nloc, unsigned& nx) {
    const unsigned G = gridDim.x * gridDim.y * gridDim.z;
    unsigned sum, cnt, mine, sp = 0u;
    for (;;) {
        sum = 0u; cnt = 0u; mine = 0u;
#pragma unroll
        for (unsigned j = 0; j < 16; ++j) { const unsigned c = xb_ld(&bar[XB_XCNT(j)]); sum += c; cnt += (c > 0u) ? 1u : 0u; mine = (j == x) ? c : mine; }
        if (sum == G) break;
        __builtin_amdgcn_s_sleep(1);
        if ((++sp & 255u) == 0u) { if (xb_ld(&bar[XB_TMO])) break; if (sp > XB_SPIN_CAP) { atomicAdd(&bar[XB_TMO], 1u); break; } }
    }
    nloc = mine > 0u ? mine : 1u; nx = cnt > 0u ? cnt : 1u;
}
__device__ __forceinline__ void xcd_barrier(const XcdBarrier& b) {
    asm volatile("s_waitcnt vmcnt(0)" ::: "memory");
    __syncthreads();
    if (threadIdx.x == 0) {
        unsigned* bar = b.bar;
        __builtin_amdgcn_s_waitcnt(0);
        unsigned nloc = b.st[0], nx = b.st[1];
        if (nloc == 0u) { xcd_barrier_complete(bar, b.x, nloc, nx); b.st[0] = nloc; b.st[1] = nx; }
        const unsigned old = xb_add(&bar[XB_XSUB(b.x)], 1u);
        const unsigned gen = old / nloc;
        if (old + 1u == (gen + 1u) * nloc) {
            __builtin_amdgcn_fence(__ATOMIC_RELEASE, "agent");
            asm volatile("s_waitcnt vmcnt(0)" ::: "memory");
            const unsigned og = xb_add(&bar[XB_TOP], 1u);
            const unsigned tg = og / nx;
            if (og + 1u == (tg + 1u) * nx) xb_add(&bar[XB_TOPGEN], 1u);
            else XB_SPIN(xb_ld(&bar[XB_TOPGEN]) == tg, bar);
            __builtin_amdgcn_fence(__ATOMIC_ACQUIRE, "agent");
            xb_add(&bar[XB_XGEN(b.x)], 1u);
            asm volatile("s_waitcnt vmcnt(0)" ::: "memory");
        } else {
            XB_SPIN(xb_ld(&bar[XB_XGEN(b.x)]) == gen, bar);
            __builtin_amdgcn_fence(__ATOMIC_ACQUIRE, "agent");
            asm volatile("s_waitcnt vmcnt(0)" ::: "memory");
        }
    }
    __syncthreads();
}

constexpr int RING_BYTES = 131072, LDSCTL_OFF = RING_BYTES, MISC_OFF = LDSCTL_OFF + 320, LDS_BYTES = 147456;
constexpr int NPH = 16;
struct Args { const float* in[31]; float* out; unsigned char* ws; int ph_lo, ph_hi; };

template <class F>
__device__ __forceinline__ void transpose_item(const F& f, bf16_t* WT, int K, int item, int nblk, LAS float* scr, int lane) {
    const int kb = item / nblk, nb = item % nblk, k0 = 64 * kb, n0 = 32 * nb;
#pragma unroll 8
    for (int i = 0; i < 32; ++i) { const int kk = 2 * i + (lane >> 5); scr[kk * 33 + (lane & 31)] = f.val(k0 + kk, n0 + (lane & 31)); }
    LDS_WAIT(); asm volatile("" ::: "memory");
    const int c = lane & 7;
#pragma unroll
    for (int j = 0; j < 4; ++j) { const int n = (lane >> 3) + 8 * j; const LAS float* s = scr + (8 * c) * 33 + n;
        u32x4 o; o.x = pk2(s[0 * 33], s[1 * 33]); o.y = pk2(s[2 * 33], s[3 * 33]); o.z = pk2(s[4 * 33], s[5 * 33]); o.w = pk2(s[6 * 33], s[7 * 33]);
        *(u32x4*)(WT + (size_t)(n0 + n) * K + k0 + 8 * c) = o; }
    LDS_WAIT(); asm volatile("" ::: "memory");
}
template <class F>
__device__ __forceinline__ void transpose_all(const F& f, bf16_t* WT, int K, int Npad, LAS float* scr, int lane, int gw, int ngw) {
    const int nblk = Npad / 32, nitems = (K / 64) * nblk;
    for (int it = gw; it < nitems; it += ngw) transpose_item(f, WT, K, it, nblk, scr, lane);
}
struct FIn0 { const float* w; const float* g; __device__ __forceinline__ float val(int k, int n) const { return w[(size_t)k * EVEN_IN + n] * g[k]; } };
struct FDt0 { const float* w; const float* g; __device__ __forceinline__ float val(int k, int n) const { return n < 16 ? w[(size_t)k * EVEN_IN + 3072 + n] * g[k] : 0.f; } };
struct FPlain { const float* w; int N; __device__ __forceinline__ float val(int k, int n) const { return w[(size_t)k * N + n]; } };
struct FOut0 { const float* w; const float* g; __device__ __forceinline__ float val(int k, int n) const { return k < 1024 ? w[(size_t)(512 + k) * 1024 + n] * g[k] : w[(size_t)(k - 1024) * 1024 + n]; } };
struct FGu { const float* wg; const float* wu; const float* g; __device__ __forceinline__ float val(int k, int n) const {
    const int tile = n >> 8, q = n & 255, j = tile * 128 + (q >> 3) * 4 + (q & 3); const long dlt = (q & 4) ? (long)(wu - wg) : 0L; return wg[dlt + (long)k * FFH + j] * g[k]; } };
struct FIn1 { const float* w; const float* g; __device__ __forceinline__ float val(int k, int n) const {
    int col; float sc = 1.f;
    if (n < 1024) { const int head = (n & 511) >> 7, pc = n & 127, i = pc >> 1, d = (pc & 1) ? i + 64 : i; col = (n < 512 ? 0 : 512) + head * 128 + d; if (n >= 512) sc = 0.08838834764831845f; }
    else if (n < 1536) { col = 3072 + (n - 1024); sc = 0.08838834764831845f; }
    else if (n < 2048) col = 3584 + (n - 1536);
    else if (n < 3072) col = 1024 + (n - 2048);
    else col = 4096 + (n - 3072);
    return w[(size_t)k * ODD_IN + col] * g[k] * sc; } };
struct FAlr { const float* w; const float* g; __device__ __forceinline__ float val(int k, int n) const { return n < 16 ? w[(size_t)k * ODD_IN + 5120 + n] * g[k] : 0.f; } };
struct FGate { const float* w; const float* g; __device__ __forceinline__ float val(int k, int n) const { const int col = n < 1024 ? 2048 + n : 5136 + (n - 1024); return w[(size_t)k * ODD_IN + col] * g[k]; } };
struct FOut1 { const float* w; const float* gr; const float* gg; __device__ __forceinline__ float val(int k, int n) const { return w[(size_t)k * 1024 + n] * (k < 1024 ? gr[k] : gg[k - 1024]); } };

__device__ __forceinline__ void s5_tables_part(const Args& A, unsigned char* ws, LAS unsigned char* lds, int g, int lb, int tid) {
    LAS f32x2* apow = (LAS f32x2*)lds;
    LAS f32x2* Cc = apow + 9 * 64;
    LAS f32x2* Bb = Cc + 1024;
    const float* lam_re = A.in[5] + g * 64; const float* lam_im = A.in[6] + g * 64;
    const float step = expf(A.in[7][g]);
    const float* b_re = A.in[8] + (size_t)g * 1024; const float* b_im = A.in[9] + (size_t)g * 1024;
    const float* c_re = A.in[10] + (size_t)g * 1024; const float* c_im = A.in[11] + (size_t)g * 1024;
    const float* dsk = A.in[12] + g * 16;
    for (int idx = tid; idx < 9 * 64; idx += NTHREADS) { const int lag = 8 * lb + (idx >> 6), p = idx & 63; const float lr = lam_re[p], li = lam_im[p];
        const float mag = expf((float)lag * (lr * step)), ang = (float)lag * (li * step); float sn, cs; sincosf(ang, &sn, &cs); apow[idx] = (f32x2){mag * cs, mag * sn}; }
    for (int idx = tid; idx < 1024; idx += NTHREADS) { Cc[idx] = (f32x2){c_re[idx], c_im[idx]};
        const int p = idx >> 4; const float lr = lam_re[p], li = lam_im[p]; const float mag = expf(lr * step); float sn, cs; sincosf(li * step, &sn, &cs);
        const float ar = mag * cs, ai = mag * sn, den = lr * lr + li * li, kr = ((ar - 1.f) * lr + ai * li) / den, ki = (ai * lr - (ar - 1.f) * li) / den;
        const float br = b_re[idx], bi = b_im[idx]; Bb[idx] = (f32x2){kr * br - ki * bi, kr * bi + ki * br}; }
    __syncthreads();
    float* kt = (float*)(ws + WS_S5K) + (size_t)(g * 64 + 8 * lb) * 256;
    for (int idx = tid; idx < 2048; idx += NTHREADS) { const int l = idx >> 8, n = (idx >> 4) & 15, m = idx & 15; float sacc = 0.f;
#pragma unroll 8
        for (int p = 0; p < 64; ++p) { const f32x2 c = Cc[n * 64 + p], a = apow[l * 64 + p], b = Bb[p * 16 + m];
            const float tr = c.x * a.x - c.y * a.y, ti = c.x * a.y + c.y * a.x; sacc += tr * b.x - ti * b.y; }
        if (lb == 0 && l == 0 && n == m) sacc += dsk[n];
        kt[idx] = sacc; }
    {
        const int i = lb >> 1, tp0 = 8 * (lb & 1);
        unsigned* bc = (unsigned*)(ws + WS_S5BC) + (size_t)g * 256 * 768;
        for (int idx = tid; idx < 128 * 64; idx += NTHREADS) { const int rr = idx >> 6, c2 = (idx & 63) * 2, tp = tp0 + (rr >> 4), n = rr & 15, l = tp - tp0 + 1; float v[2];
#pragma unroll
            for (int e = 0; e < 2; ++e) { const int pp = c2 + e, p = pp & 63; const f32x2 cc = Cc[n * 64 + p], a = apow[l * 64 + p];
                v[e] = pp < 64 ? (cc.x * a.x - cc.y * a.y) : -(cc.x * a.y + cc.y * a.x); }
            bc[(size_t)(tp * 16 + n) * 768 + (1024 + 128 * i + c2) / 2] = pk2(v[0], v[1]); }
    }
    {
        unsigned* w1 = (unsigned*)(ws + WS_S5W1) + (size_t)g * 128 * 512;
        for (int idx = tid; idx < 128 * 64; idx += NTHREADS) { const int pp = idx >> 6, q = idx & 63, l = q >> 3, m2 = (q & 7) * 2, sidx = 63 - 8 * lb - l, p = pp & 63; float v[2];
#pragma unroll
            for (int e = 0; e < 2; ++e) { const f32x2 a = apow[l * 64 + p], b = Bb[p * 16 + m2 + e]; v[e] = pp < 64 ? (a.x * b.x - a.y * b.y) : (a.x * b.y + a.y * b.x); }
            w1[(size_t)pp * 512 + (sidx * 16 + m2) / 2] = pk2(v[0], v[1]); }
    }
    if (lb == 7 && tid < 64) *(f32x2*)((float*)(ws + WS_A64) + (size_t)(g * 64 + tid) * 2) = apow[8 * 64 + tid];
    __syncthreads();
}
__device__ __forceinline__ void s5_expand(unsigned char* ws, int gtid, int ngt) {
    const float* kt = (const float*)(ws + WS_S5K); unsigned* bc = (unsigned*)(ws + WS_S5BC);
    for (int idx = gtid; idx < 32 * 256 * 512; idx += ngt) {
        const int g = idx >> 17, r = (idx >> 9) & 255, c2 = (idx & 511) * 2, tp = r >> 4, n = r & 15, d = 3 - (c2 >> 8), kk = c2 & 255, sp = kk >> 4, m = kk & 15, lag = 16 * d + tp - sp;
        unsigned w = 0u;
        if (lag >= 0) { const f32x2 v = *(const f32x2*)(kt + (size_t)(g * 64 + lag) * 256 + n * 16 + m); w = pk2(v.x, v.y); }
        bc[(size_t)(g * 256 + r) * 768 + (c2 >> 1)] = w;
    }
}

__device__ __forceinline__ void skinny16(const bf16_t* hb, const bf16_t* wt, const float* ssq, float* out, int gw, int ngw, int lane) {
    for (int task = gw; task < T / 16; task += ngw) {
        const int r0 = task * 16; f32x4 acc = (f32x4){0.f, 0.f, 0.f, 0.f};
        const bf16_t* ap = hb + (size_t)(r0 + (lane & 15)) * 1024 + (lane >> 4) * 8; const bf16_t* bp = wt + (size_t)(lane & 15) * 1024 + (lane >> 4) * 8;
#pragma unroll 4
        for (int kk = 0; kk < 32; ++kk) { const bf16x8 a = *(const bf16x8*)(ap + kk * 32), b = *(const bf16x8*)(bp + kk * 32); acc = __builtin_amdgcn_mfma_f32_16x16x32_bf16(a, b, acc, 0, 0, 0); }
#pragma unroll
        for (int j = 0; j < 4; ++j) { const int row = r0 + (lane >> 4) * 4 + j; out[(size_t)row * 16 + (lane & 15)] = acc[j] * row_rstd(ssq, row); }
    }
}

template <int STRIDE>
__device__ __forceinline__ bf16x8 ldfrag(const LAS unsigned char* base, int row0, int k0, int lane) {
    return *(const LAS bf16x8*)(base + (row0 + (lane & 15)) * STRIDE + (k0 + (lane >> 4) * 8) * 2);
}
#define MFMA16(a, b, c) __builtin_amdgcn_mfma_f32_16x16x32_bf16(a, b, c, 0, 0, 0)
__device__ __forceinline__ u32x2 pack4(const f32x4 v) { u32x2 w; w.x = cvt_pk_bf16(v[0], v[1]); w.y = cvt_pk_bf16(v[2], v[3]); return w; }
__device__ __forceinline__ u32x4 pack8f(const float (&v)[8]) { u32x4 w; w.x = cvt_pk_bf16(v[0], v[1]); w.y = cvt_pk_bf16(v[2], v[3]); w.z = cvt_pk_bf16(v[4], v[5]); w.w = cvt_pk_bf16(v[6], v[7]); return w; }

constexpr int M1_QP = 0, M1_KN = 17408, M1_KDT = 34816, M1_VT = 53248, M1_P = 62464, M1_ST = 71680, M1_XCH = 106496, M1_EDEC = 110592;
__device__ __forceinline__ void mix1_item(LAS unsigned char* lds, unsigned char* ws, int item, int wave, int lane) {
    const int mixer = item >> 7, b = (item >> 4) & 7, h = (item >> 2) & 3, vq = item & 3;
    const bf16_t* qkv = (const bf16_t*)(ws + WS_QKV); const bf16_t* loga = (const bf16_t*)(ws + WS_LOGA);
    bf16_t* out = (bf16_t*)(ws + WS_QKV);
    const int qoff = (mixer ? 1024 : 0) + h * 128 + 2 * lane, koff = qoff + 512, vcol = 2048 + (mixer ? 1024 : 0) + h * 256 + vq * 64;
    const float lgam = logf(1.0f - exp2f(-5.0f - (float)h));
    const int mt = wave >> 1, nt0 = (wave & 1) * 2, dt0 = (wave & 1) * 4;
    f32x4 accs[4], o0 = (f32x4){0.f, 0.f, 0.f, 0.f}, o1 = o0;
#pragma unroll
    for (int i = 0; i < 4; ++i) accs[i] = (f32x4){0.f, 0.f, 0.f, 0.f};
    unsigned qr[2][8], kr[2][8], lr[2][8], vr[2][8];
#define M1_LOAD(c, u) do { _Pragma("unroll") for (int t = 0; t < 8; ++t) { const size_t row = (size_t)b * SEQ + (c) * 64 + 8 * wave + t; const bf16_t* rp = qkv + row * 4096; \
        qr[u][t] = *(const unsigned*)(rp + qoff); kr[u][t] = *(const unsigned*)(rp + koff); vr[u][t] = rp[vcol + lane]; \
        lr[u][t] = mixer ? *(const unsigned*)(loga + row * 512 + h * 128 + 2 * lane) : 0u; } } while (0)
    M1_LOAD(0, 0); M1_LOAD(1, 1);
    for (int c2 = 0; c2 < 16; ++c2) {
#pragma unroll
      for (int u = 0; u < 2; ++u) {
        const int c = 2 * c2 + u;
        const int cur = u, nxt = u ^ 1;
        float c0[8], c1[8], run0 = 0.f, run1 = 0.f;
#pragma unroll
        for (int t = 0; t < 8; ++t) { const float la0 = mixer ? bflo(lr[u][t]) : lgam, la1 = mixer ? bfhi(lr[u][t]) : lgam; run0 += la0; run1 += la1; c0[t] = run0; c1[t] = run1; }
        *(LAS f32x2*)(lds + M1_XCH + (wave * 128 + 2 * lane) * 4) = (f32x2){run0, run1};
        __syncthreads();
        float pre0 = 0.f, pre1 = 0.f, tot0 = 0.f, tot1 = 0.f;
#pragma unroll
        for (int w2 = 0; w2 < 8; ++w2) { const f32x2 x = *(const LAS f32x2*)(lds + M1_XCH + (w2 * 128 + 2 * lane) * 4); tot0 += x.x; tot1 += x.y; if (w2 < wave) { pre0 += x.x; pre1 += x.y; } }
        float kd0[8], kd1[8];
#pragma unroll
        for (int t = 0; t < 8; ++t) {
            const float b0 = pre0 + c0[t], b1 = pre1 + c1[t];
            const float ep0 = __expf(b0), ep1 = __expf(b1), en0 = __expf(-b0), en1 = __expf(-b1), ed0 = __expf(tot0 - b0), ed1 = __expf(tot1 - b1);
            const float q0 = bflo(qr[u][t]), q1 = bfhi(qr[u][t]), k0 = bflo(kr[u][t]), k1 = bfhi(kr[u][t]);
            *(LAS unsigned*)(lds + M1_QP + (8 * wave + t) * 272 + 4 * lane) = cvt_pk_bf16(q0 * ep0, q1 * ep1);
            *(LAS unsigned*)(lds + M1_KN + (8 * wave + t) * 272 + 4 * lane) = cvt_pk_bf16(k0 * en0, k1 * en1);
            kd0[t] = k0 * ed0; kd1[t] = k1 * ed1;
        }
        *(LAS u32x4*)(lds + M1_KDT + (2 * lane) * 144 + 16 * wave) = pack8f(kd0);
        *(LAS u32x4*)(lds + M1_KDT + (2 * lane + 1) * 144 + 16 * wave) = pack8f(kd1);
        if (wave == 0) *(LAS f32x2*)(lds + M1_EDEC + 8 * lane) = (f32x2){__expf(tot0), __expf(tot1)};
        { u32x4 vv; vv.x = vr[u][0] | (vr[u][1] << 16); vv.y = vr[u][2] | (vr[u][3] << 16); vv.z = vr[u][4] | (vr[u][5] << 16); vv.w = vr[u][6] | (vr[u][7] << 16); *(LAS u32x4*)(lds + M1_VT + lane * 144 + 16 * wave) = vv; }
        if (c + 2 < 32) M1_LOAD(c + 2, u);
        __syncthreads();
        bf16x8 qa[4];
#pragma unroll
        for (int ks = 0; ks < 4; ++ks) qa[ks] = ldfrag<272>(lds + M1_QP, 16 * mt, 32 * ks, lane);
        f32x4 p0 = (f32x4){0.f, 0.f, 0.f, 0.f}, p1 = p0;
#pragma unroll
        for (int ks = 0; ks < 4; ++ks) { const bf16x8 k0f = ldfrag<272>(lds + M1_KN, 16 * nt0, 32 * ks, lane), k1f = ldfrag<272>(lds + M1_KN, 16 * (nt0 + 1), 32 * ks, lane);
            p0 = MFMA16(k0f, qa[ks], p0); p1 = MFMA16(k1f, qa[ks], p1); }
        const int ii = 16 * mt + (lane & 15);
        { const int j0 = 16 * nt0 + 4 * (lane >> 4), j1 = j0 + 16;
#pragma unroll
          for (int r = 0; r < 4; ++r) { if (j0 + r > ii) p0[r] = 0.f; if (j1 + r > ii) p1[r] = 0.f; }
          *(LAS u32x2*)(lds + M1_P + ii * 144 + j0 * 2) = pack4(p0); *(LAS u32x2*)(lds + M1_P + ii * 144 + j1 * 2) = pack4(p1); }
        if (c > 0) {
#pragma unroll
            for (int ks = 0; ks < 4; ++ks) { const bf16x8 s0 = ldfrag<272>(lds + M1_ST + cur * 17408, 16 * nt0, 32 * ks, lane), s1 = ldfrag<272>(lds + M1_ST + cur * 17408, 16 * (nt0 + 1), 32 * ks, lane);
                o0 = MFMA16(s0, qa[ks], o0); o1 = MFMA16(s1, qa[ks], o1); }
        }
#pragma unroll
        for (int dtl = 0; dtl < 4; ++dtl) { const f32x4 e = *(const LAS f32x4*)(lds + M1_EDEC + (16 * (dt0 + dtl) + 4 * (lane >> 4)) * 4); accs[dtl] = accs[dtl] * e; }
#pragma unroll
        for (int ks = 0; ks < 2; ++ks) { const bf16x8 va = ldfrag<144>(lds + M1_VT, 16 * mt, 32 * ks, lane);
#pragma unroll
            for (int dtl = 0; dtl < 4; ++dtl) { const bf16x8 kb = ldfrag<144>(lds + M1_KDT, 16 * (dt0 + dtl), 32 * ks, lane); accs[dtl] = MFMA16(kb, va, accs[dtl]); } }
#pragma unroll
        for (int dtl = 0; dtl < 4; ++dtl) *(LAS u32x2*)(lds + M1_ST + nxt * 17408 + ii * 272 + (16 * (dt0 + dtl) + 4 * (lane >> 4)) * 2) = pack4(accs[dtl]);
        __syncthreads();
#pragma unroll
        for (int ks = 0; ks < 2; ++ks) { const bf16x8 pa = ldfrag<144>(lds + M1_P, 16 * mt, 32 * ks, lane), v0 = ldfrag<144>(lds + M1_VT, 16 * nt0, 32 * ks, lane), v1 = ldfrag<144>(lds + M1_VT, 16 * (nt0 + 1), 32 * ks, lane);
            o0 = MFMA16(v0, pa, o0); o1 = MFMA16(v1, pa, o1); }
        { bf16_t* op = out + ((size_t)b * SEQ + c * 64 + ii) * 4096 + vcol + 16 * nt0 + 4 * (lane >> 4);
          *(u32x2*)op = pack4(o0); *(u32x2*)(op + 16) = pack4(o1); }
        o0 = (f32x4){0.f, 0.f, 0.f, 0.f}; o1 = o0;
      }
    }
    __syncthreads();
#undef M1_LOAD
}

constexpr int M2_VT = 0, M2_KDT = 36864, M2_P = 55296, M2_XCH = 64512, M2_EDEC = 68608, M2_RS = 69120, M2_QP = 73216, M2_KN = 90624;
template <bool PB>
__device__ __forceinline__ void mix2_item(LAS unsigned char* lds, unsigned char* ws, int item, int wave, int lane) {
    const int mixer = item >> 7, b = (item >> 4) & 7, h = (item >> 2) & 3, seg = item & 3;
    if (!PB && seg == 3) return;
    const bf16_t* qkv = (const bf16_t*)(ws + WS_QKV); const bf16_t* loga = (const bf16_t*)(ws + WS_LOGA);
    bf16_t* out = (bf16_t*)(ws + WS_QKV);
    bf16_t* sloc = (bf16_t*)(ws + WS_SLOC); float* ltotg = (float*)(ws + WS_LTOT);
    const int slot0 = ((mixer * 8 + b) * 4 + h) * 3;
    const int qoff = (mixer ? 1024 : 0) + h * 128 + 2 * lane, koff = qoff + 512, vcol0 = 2048 + (mixer ? 1024 : 0) + h * 256;
    const float lgam = logf(1.0f - exp2f(-5.0f - (float)h));
    const size_t rowseg = (size_t)b * SEQ + seg * 512;
    const int q4 = lane >> 4, l15 = lane & 15;
    const __amdgpu_buffer_rsrc_t rq = __builtin_amdgcn_make_buffer_rsrc(ws + WS_QKV, 0, (int)((size_t)T * 4096 * 2), 0x00020000);
    const __amdgpu_buffer_rsrc_t rl = __builtin_amdgcn_make_buffer_rsrc(ws + WS_LOGA, 0, (int)((size_t)T * 512 * 2), 0x00020000);
    const int voq = qoff * 2, vov = (vcol0 + 2 * lane) * 2, vol = (h * 128 + 2 * lane) * 2;
    const int voo = l15 * 8192 + (vcol0 + 32 * wave + 8 * q4) * 2;
    const LAS unsigned char* b144 = lds + l15 * 144 + q4 * 16;
    const LAS unsigned char* b272 = lds + M2_QP + l15 * 272 + q4 * 16;
    const int vperm = 8 * (l15 >> 2) + (l15 & 3);
    const LAS unsigned char* bv = lds + (32 * wave + vperm) * 144 + q4 * 16;
#define F144(tile, row0, k0) (*(const LAS bf16x8*)(b144 + ((tile) + (row0) * 144 + (k0) * 2)))
#define F272(tile, row0, k0) (*(const LAS bf16x8*)(b272 + (((tile) - M2_QP) + (row0) * 272 + (k0) * 2)))
#define FV(vt, k0) (*(const LAS bf16x8*)(bv + (M2_VT + (vt) * (4 * 144) + (k0) * 2)))
    f32x4 accs[2][8];
#pragma unroll
    for (int vt = 0; vt < 2; ++vt)
#pragma unroll
        for (int dt = 0; dt < 8; ++dt) accs[vt][dt] = (f32x4){0.f, 0.f, 0.f, 0.f};
    if (PB) {
        for (int s2 = 0; s2 < seg; ++s2) {
#pragma unroll
            for (int dt = 0; dt < 8; ++dt) {
                f32x4 lw = (f32x4){0.f, 0.f, 0.f, 0.f};
                for (int s3 = s2 + 1; s3 < seg; ++s3) lw += *(const f32x4*)(ltotg + (size_t)(slot0 + s3) * 128 + 16 * dt + 4 * q4);
                f32x4 wgt; wgt[0] = __expf(lw[0]); wgt[1] = __expf(lw[1]); wgt[2] = __expf(lw[2]); wgt[3] = __expf(lw[3]);
#pragma unroll
                for (int vt = 0; vt < 2; ++vt) { const u32x2 w = *(const u32x2*)(sloc + ((size_t)(slot0 + s2) * 256 + 32 * wave + vperm + 4 * vt) * 128 + 16 * dt + 4 * q4);
                    accs[vt][dt][0] += wgt[0] * bflo(w.x); accs[vt][dt][1] += wgt[1] * bfhi(w.x); accs[vt][dt][2] += wgt[2] * bflo(w.y); accs[vt][dt][3] += wgt[3] * bfhi(w.y); }
            }
        }
    }
    f32x4 oacc[4][2];
#pragma unroll
    for (int mt = 0; mt < 4; ++mt) { oacc[mt][0] = (f32x4){0.f, 0.f, 0.f, 0.f}; oacc[mt][1] = oacc[mt][0]; }
    float lt0 = 0.f, lt1 = 0.f;
    constexpr int D = PB ? 1 : 2;
    unsigned qr[8], kr[D][8], lr[D][8], vr[D][16];
#define M2_LOAD_E(c, u) do { _Pragma("unroll") for (int t = 0; t < 8; ++t) { const int srow = (int)(rowseg + (c) * 64 + 8 * wave + t); \
        if (PB) qr[t] = __builtin_amdgcn_raw_buffer_load_b32(rq, voq, srow * 8192, 0); kr[u][t] = __builtin_amdgcn_raw_buffer_load_b32(rq, voq + 1024, srow * 8192, 0); \
        lr[u][t] = mixer ? __builtin_amdgcn_raw_buffer_load_b32(rl, vol, srow * 1024, 0) : 0u; } } while (0)
#define M2_LOAD_V(c, u) do { _Pragma("unroll") for (int t = 0; t < 8; ++t) { const int srow = (int)(rowseg + (c) * 64 + 8 * wave + t); \
        vr[u][2 * t] = __builtin_amdgcn_raw_buffer_load_b32(rq, vov, srow * 8192, 0); vr[u][2 * t + 1] = __builtin_amdgcn_raw_buffer_load_b32(rq, vov + 256, srow * 8192, 0); } } while (0)
#define M2_LOAD(c, u) do { M2_LOAD_E(c, u); M2_LOAD_V(c, u); } while (0)
#define M2_STATS() do { _Pragma("unroll") for (int mt = 0; mt < 4; ++mt) { const f32x4 a = oacc[mt][0], bb = oacc[mt][1]; \
        float s1 = ((a[0] + a[1]) + (a[2] + a[3])) + ((bb[0] + bb[1]) + (bb[2] + bb[3])); \
        float s2 = ((a[0] * a[0] + a[1] * a[1]) + (a[2] * a[2] + a[3] * a[3])) + ((bb[0] * bb[0] + bb[1] * bb[1]) + (bb[2] * bb[2] + bb[3] * bb[3])); \
        s1 += __shfl_xor(s1, 16); s1 += __shfl_xor(s1, 32); s2 += __shfl_xor(s2, 16); s2 += __shfl_xor(s2, 32); \
        if (lane < 16) *(LAS f32x2*)(lds + M2_RS + ((16 * mt + lane) * 8 + wave) * 8) = (f32x2){s1, s2}; } } while (0)
#define M2_STORE(c) do { _Pragma("unroll") for (int mt = 0; mt < 4; ++mt) { const LAS f32x4* rs = (const LAS f32x4*)(lds + M2_RS + (16 * mt + l15) * 64); \
        const f32x4 r0 = rs[0], r1 = rs[1], r2 = rs[2], r3 = rs[3]; \
        const float s1 = ((r0[0] + r0[2]) + (r1[0] + r1[2])) + ((r2[0] + r2[2]) + (r3[0] + r3[2])), s2 = ((r0[1] + r0[3]) + (r1[1] + r1[3])) + ((r2[1] + r2[3]) + (r3[1] + r3[3])); \
        float mu = 0.f, rstd; \
        if (!mixer) { mu = s1 * (1.0f / 256.0f); rstd = rsqrtf(fmaxf(s2 * (1.0f / 256.0f) - mu * mu, 0.f) + EPS); } else rstd = rsqrtf(s2 * (1.0f / 256.0f) + EPS); \
        const int so = (int)(rowseg + (c) * 64 + 16 * mt) * 8192; \
        { const u32x2 w0 = pack4((oacc[mt][0] - mu) * rstd), w1 = pack4((oacc[mt][1] - mu) * rstd); u32x4 w; w.x = w0.x; w.y = w0.y; w.z = w1.x; w.w = w1.y; __builtin_amdgcn_raw_buffer_store_b128(w, rq, voo, so, 0); } \
        oacc[mt][0] = (f32x4){0.f, 0.f, 0.f, 0.f}; oacc[mt][1] = oacc[mt][0]; } } while (0)
    M2_LOAD(0, 0); if (!PB) M2_LOAD(1, D - 1);
    for (int cc = 0; cc < 8; cc += D) {
#pragma unroll
      for (int u = 0; u < D; ++u) {
        const int c = cc + u;
        { float run0 = 0.f, run1 = 0.f;
#pragma unroll
          for (int t = 0; t < 8; ++t) { run0 += mixer ? bflo(lr[u][t]) : lgam; run1 += mixer ? bfhi(lr[u][t]) : lgam; }
          *(LAS f32x2*)(lds + M2_XCH + (wave * 128 + 2 * lane) * 4) = (f32x2){run0, run1}; }
        if (PB) { if (c > 0) M2_STATS(); }
        __syncthreads();
        if (PB) { if (c > 0) M2_STORE(c - 1); }
        float pre0 = 0.f, pre1 = 0.f, tot0 = 0.f, tot1 = 0.f;
#pragma unroll
        for (int w2 = 0; w2 < 8; ++w2) { const f32x2 x = *(const LAS f32x2*)(lds + M2_XCH + (w2 * 128 + 2 * lane) * 4); tot0 += x.x; tot1 += x.y; if (w2 < wave) { pre0 += x.x; pre1 += x.y; } }
        lt0 += tot0; lt1 += tot1;
        { float kd0[8], kd1[8];
#pragma unroll
          for (int t = 0; t < 8; ++t) {
            pre0 += mixer ? bflo(lr[u][t]) : lgam; pre1 += mixer ? bfhi(lr[u][t]) : lgam;
            const float b0 = pre0, b1 = pre1;
            const float en0 = __expf(-b0), en1 = __expf(-b1);
            const float k0 = bflo(kr[u][t]), k1 = bfhi(kr[u][t]);
            if (PB) { const float ep0 = __expf(b0), ep1 = __expf(b1), q0 = bflo(qr[t]), q1 = bfhi(qr[t]);
                *(LAS unsigned*)(lds + M2_QP + (8 * wave + t) * 272 + 4 * lane) = cvt_pk_bf16(q0 * ep0, q1 * ep1);
                *(LAS unsigned*)(lds + M2_KN + (8 * wave + t) * 272 + 4 * lane) = cvt_pk_bf16(k0 * en0, k1 * en1); }
            kd0[t] = k0 * en0; kd1[t] = k1 * en1;
          }
          const float et0 = __expf(tot0), et1 = __expf(tot1);
#pragma unroll
          for (int t = 0; t < 8; ++t) { kd0[t] *= et0; kd1[t] *= et1; }
          *(LAS u32x4*)(lds + M2_KDT + (2 * lane) * 144 + 16 * wave) = pack8f(kd0);
          *(LAS u32x4*)(lds + M2_KDT + (2 * lane + 1) * 144 + 16 * wave) = pack8f(kd1);
          if (wave == 0) *(LAS f32x2*)(lds + M2_EDEC + 8 * lane) = (f32x2){et0, et1};
        }
#pragma unroll
        for (int k = 0; k < 2; ++k) {
            u32x4 ve, vo;
            ve.x = (vr[u][k] & 0xffffu) | (vr[u][2 + k] << 16); ve.y = (vr[u][4 + k] & 0xffffu) | (vr[u][6 + k] << 16); ve.z = (vr[u][8 + k] & 0xffffu) | (vr[u][10 + k] << 16); ve.w = (vr[u][12 + k] & 0xffffu) | (vr[u][14 + k] << 16);
            vo.x = (vr[u][k] >> 16) | (vr[u][2 + k] & 0xffff0000u); vo.y = (vr[u][4 + k] >> 16) | (vr[u][6 + k] & 0xffff0000u); vo.z = (vr[u][8 + k] >> 16) | (vr[u][10 + k] & 0xffff0000u); vo.w = (vr[u][12 + k] >> 16) | (vr[u][14 + k] & 0xffff0000u);
            *(LAS u32x4*)(lds + M2_VT + (128 * k + 2 * lane) * 144 + 16 * wave) = ve;
            *(LAS u32x4*)(lds + M2_VT + (128 * k + 2 * lane + 1) * 144 + 16 * wave) = vo; }
        if (c + D < 8) { M2_LOAD_E(c + D, u); if (!PB) M2_LOAD_V(c + D, u); }
        __syncthreads();
        if (PB) {
            const int mt1 = wave >> 1, nt0 = (wave & 1) * 2;
            f32x4 p0 = (f32x4){0.f, 0.f, 0.f, 0.f}, p1 = p0;
#pragma unroll
            for (int ks = 0; ks < 4; ++ks) { const bf16x8 qa = *(const LAS bf16x8*)(b272 + mt1 * (16 * 272) + 64 * ks), k0f = *(const LAS bf16x8*)(b272 + 17408 + nt0 * (16 * 272) + 64 * ks), k1f = *(const LAS bf16x8*)(b272 + 17408 + (nt0 + 1) * (16 * 272) + 64 * ks);
                p0 = MFMA16(k0f, qa, p0); p1 = MFMA16(k1f, qa, p1); }
            { const int ii = 16 * mt1 + l15, j0 = 16 * nt0 + 4 * q4, j1 = j0 + 16;
#pragma unroll
              for (int r = 0; r < 4; ++r) { if (j0 + r > ii) p0[r] = 0.f; if (j1 + r > ii) p1[r] = 0.f; }
              *(LAS u32x2*)(lds + M2_P + ii * 144 + j0 * 2) = pack4(p0); *(LAS u32x2*)(lds + M2_P + ii * 144 + j1 * 2) = pack4(p1); }
#pragma unroll
            for (int ks = 0; ks < 4; ++ks) {
                bf16x8 sf[2];
#pragma unroll
                for (int vt = 0; vt < 2; ++vt) { const u32x2 lo = pack4(accs[vt][2 * ks]), hi = pack4(accs[vt][2 * ks + 1]); u32x4 w; w.x = lo.x; w.y = lo.y; w.z = hi.x; w.w = hi.y; sf[vt] = __builtin_bit_cast(bf16x8, w); }
#pragma unroll
                for (int mt = 0; mt < 4; ++mt) {
                    const LAS unsigned char* qp = b272 - q4 * 8 + (mt * (16 * 272) + 64 * ks);
                    const u32x2 a0 = *(const LAS u32x2*)qp, a1 = *(const LAS u32x2*)(qp + 32); u32x4 w; w.x = a0.x; w.y = a0.y; w.z = a1.x; w.w = a1.y; const bf16x8 qf = __builtin_bit_cast(bf16x8, w);
                    oacc[mt][0] = MFMA16(sf[0], qf, oacc[mt][0]); oacc[mt][1] = MFMA16(sf[1], qf, oacc[mt][1]);
                }
                __builtin_amdgcn_sched_barrier(0);
            }
        }
#pragma unroll
        for (int dt = 0; dt < 8; ++dt) { const f32x4 e = *(const LAS f32x4*)(lds + M2_EDEC + (16 * dt + 4 * q4) * 4); accs[0][dt] = accs[0][dt] * e; accs[1][dt] = accs[1][dt] * e; }
#pragma unroll
        for (int ks = 0; ks < 2; ++ks) {
            const bf16x8 v0f = FV(0, 32 * ks), v1f = FV(1, 32 * ks);
#pragma unroll
            for (int dt = 0; dt < 8; ++dt) { const bf16x8 kb = F144(M2_KDT, 16 * dt, 32 * ks); accs[0][dt] = MFMA16(kb, v0f, accs[0][dt]); accs[1][dt] = MFMA16(kb, v1f, accs[1][dt]); }
            __builtin_amdgcn_sched_barrier(0);
        }
        if (PB) {
            __syncthreads();
            if (c + 1 < 8) M2_LOAD_V(c + 1, 0);
#pragma unroll
            for (int ks = 0; ks < 2; ++ks) {
                const bf16x8 v0f = FV(0, 32 * ks), v1f = FV(1, 32 * ks);
#pragma unroll
                for (int mt = 0; mt < 4; ++mt) { const bf16x8 pa = F144(M2_P, 16 * mt, 32 * ks); oacc[mt][0] = MFMA16(v0f, pa, oacc[mt][0]); oacc[mt][1] = MFMA16(v1f, pa, oacc[mt][1]); }
            }
        }
      }
    }
    if (PB) {
        M2_STATS();
        __syncthreads();
        M2_STORE(7);
    } else {
#pragma unroll
        for (int vt = 0; vt < 2; ++vt)
#pragma unroll
            for (int dt = 0; dt < 8; ++dt) *(u32x2*)(sloc + ((size_t)(slot0 + seg) * 256 + 32 * wave + vperm + 4 * vt) * 128 + 16 * dt + 4 * q4) = pack4(accs[vt][dt]);
        if (wave == 0) *(f32x2*)(ltotg + (size_t)(slot0 + seg) * 128 + 2 * lane) = (f32x2){lt0, lt1};
    }
    __syncthreads();
#undef M2_LOAD
#undef M2_LOAD_E
#undef M2_LOAD_V
#undef M2_STATS
#undef M2_STORE
#undef F144
#undef F272
#undef FV
}

constexpr int S_CA = 0, S_CP = 9216, S_BN = 18432, S_BDT = 27648, S_XT = 36864, S_XS = 46080, S_P = 55296, S_ST = 64512;
__device__ __forceinline__ void ssd_item(LAS unsigned char* lds, unsigned char* ws, const float* cw, const float* cb, float dt_bias, float aneg, float dsk, int item, int wave, int lane) {
    const int b = item >> 4, h = item & 15, g = h >> 2;
    const bf16_t* xbc = (const bf16_t*)(ws + WS_XBC); const bf16_t* zs = (const bf16_t*)(ws + WS_ZS); const float* dtb = (const float*)(ws + WS_DT);
    bf16_t* yab = (bf16_t*)(ws + WS_YAB); float* ssqb = (float*)(ws + WS_SSQB);
    const int cx = h * 64 + lane, cB = 1024 + g * 64 + lane, cC = 1280 + g * 64 + lane;
    float wx[4], wb[4], wc_[4];
#pragma unroll
    for (int k = 0; k < 4; ++k) { wx[k] = cw[k * 1536 + cx]; wb[k] = cw[k * 1536 + cB]; wc_[k] = cw[k * 1536 + cC]; }
    const float bx_ = cb[cx], bb_ = cb[cB], bc_ = cb[cC];
    const int mt = wave >> 1, nt0 = (wave & 1) * 2;
    f32x4 accs0 = (f32x4){0.f, 0.f, 0.f, 0.f}, accs1 = accs0, o0 = accs0, o1 = accs0;
    unsigned xr[2][11], br[2][11], cr[2][11]; float dtr[2];
#define SSD_LOAD(c, u) do { _Pragma("unroll") for (int rr = 0; rr < 11; ++rr) { const int trow = (c) * 64 + 8 * wave - 3 + rr; \
        if (trow >= 0) { const bf16_t* rp = xbc + ((size_t)b * SEQ + trow) * 1536; xr[u][rr] = rp[cx]; br[u][rr] = rp[cB]; cr[u][rr] = rp[cC]; } else { xr[u][rr] = 0u; br[u][rr] = 0u; cr[u][rr] = 0u; } } \
        dtr[u] = dtb[((size_t)b * SEQ + (c) * 64 + lane) * 16 + h]; } while (0)
    SSD_LOAD(0, 0); SSD_LOAD(1, 1);
    for (int c2 = 0; c2 < 16; ++c2) {
#pragma unroll
      for (int u = 0; u < 2; ++u) {
        const int c = 2 * c2 + u;
        const int cur = u, nxt = u ^ 1;
        const size_t row0 = (size_t)b * SEQ + c * 64;
        const int ii = 16 * mt + (lane & 15);
        const u32x2 z0 = *(const u32x2*)(zs + (row0 + ii) * 1024 + h * 64 + 16 * nt0 + 4 * (lane >> 4)), z1 = *(const u32x2*)(zs + (row0 + ii) * 1024 + h * 64 + 16 * nt0 + 16 + 4 * (lane >> 4));
        const float dr = dtr[u] + dt_bias, dt = dr > 20.f ? dr : log1pf(__expf(dr));
        float acum = aneg * dt;
#pragma unroll
        for (int o = 1; o < 64; o <<= 1) { const float v = __shfl_up(acum, o); if (lane >= o) acum += v; }
        const float a63 = __int_as_float(__builtin_amdgcn_readlane(__float_as_int(acum), 63));
        float xd[8], bd[8];
#pragma unroll
        for (int t = 0; t < 8; ++t) {
            const int tok = 8 * wave + t;
            const float dt_t = __int_as_float(__builtin_amdgcn_readlane(__float_as_int(dt), tok)), ac_t = __int_as_float(__builtin_amdgcn_readlane(__float_as_int(acum), tok));
            float xv = bx_, bv = bb_, cv = bc_;
#pragma unroll
            for (int k = 0; k < 4; ++k) { xv += wx[k] * bf2f(xr[u][t + k]); bv += wb[k] * bf2f(br[u][t + k]); cv += wc_[k] * bf2f(cr[u][t + k]); }
            xv = siluf_(xv); bv = siluf_(bv); cv = siluf_(cv);
            xd[t] = xv * dt_t; bd[t] = bv * __expf(a63 - ac_t);
            *(LAS bf16_t*)(lds + S_XS + tok * 144 + 2 * lane) = (bf16_t)f2bf(xv);
            *(LAS bf16_t*)(lds + S_BN + tok * 144 + 2 * lane) = (bf16_t)f2bf(bv);
            *(LAS bf16_t*)(lds + S_CA + tok * 144 + 2 * lane) = (bf16_t)f2bf(cv);
            *(LAS bf16_t*)(lds + S_CP + tok * 144 + 2 * lane) = (bf16_t)f2bf(cv * __expf(ac_t));
        }
        *(LAS u32x4*)(lds + S_XT + lane * 144 + 16 * wave) = pack8f(xd);
        *(LAS u32x4*)(lds + S_BDT + lane * 144 + 16 * wave) = pack8f(bd);
        if (c + 2 < 32) SSD_LOAD(c + 2, u);
        __syncthreads();
        bf16x8 ca[2];
#pragma unroll
        for (int ks = 0; ks < 2; ++ks) ca[ks] = ldfrag<144>(lds + S_CA, 16 * mt, 32 * ks, lane);
        f32x4 p0 = (f32x4){0.f, 0.f, 0.f, 0.f}, p1 = p0;
#pragma unroll
        for (int ks = 0; ks < 2; ++ks) { const bf16x8 b0f = ldfrag<144>(lds + S_BN, 16 * nt0, 32 * ks, lane), b1f = ldfrag<144>(lds + S_BN, 16 * (nt0 + 1), 32 * ks, lane);
            p0 = MFMA16(b0f, ca[ks], p0); p1 = MFMA16(b1f, ca[ks], p1); }
        { const float al = __shfl(acum, ii); const int j0 = 16 * nt0 + 4 * (lane >> 4), j1 = j0 + 16;
#pragma unroll
          for (int r = 0; r < 4; ++r) { const float as0 = __shfl(acum, j0 + r), as1 = __shfl(acum, j1 + r);
              p0[r] = (j0 + r <= ii) ? p0[r] * __expf(al - as0) : 0.f; p1[r] = (j1 + r <= ii) ? p1[r] * __expf(al - as1) : 0.f; }
          *(LAS u32x2*)(lds + S_P + ii * 144 + j0 * 2) = pack4(p0); *(LAS u32x2*)(lds + S_P + ii * 144 + j1 * 2) = pack4(p1); }
        if (c > 0) {
#pragma unroll
            for (int ks = 0; ks < 2; ++ks) { const bf16x8 cp = ldfrag<144>(lds + S_CP, 16 * mt, 32 * ks, lane), s0 = ldfrag<144>(lds + S_ST + cur * 9216, 16 * nt0, 32 * ks, lane), s1 = ldfrag<144>(lds + S_ST + cur * 9216, 16 * (nt0 + 1), 32 * ks, lane);
                o0 = MFMA16(s0, cp, o0); o1 = MFMA16(s1, cp, o1); }
        }
        { const float e63 = __expf(a63); accs0 = accs0 * e63; accs1 = accs1 * e63; }
#pragma unroll
        for (int ks = 0; ks < 2; ++ks) { const bf16x8 xa = ldfrag<144>(lds + S_XT, 16 * mt, 32 * ks, lane), n0 = ldfrag<144>(lds + S_BDT, 16 * nt0, 32 * ks, lane), n1 = ldfrag<144>(lds + S_BDT, 16 * (nt0 + 1), 32 * ks, lane);
            accs0 = MFMA16(n0, xa, accs0); accs1 = MFMA16(n1, xa, accs1); }
        *(LAS u32x2*)(lds + S_ST + nxt * 9216 + ii * 144 + (16 * nt0 + 4 * (lane >> 4)) * 2) = pack4(accs0);
        *(LAS u32x2*)(lds + S_ST + nxt * 9216 + ii * 144 + (16 * nt0 + 16 + 4 * (lane >> 4)) * 2) = pack4(accs1);
        __syncthreads();
#pragma unroll
        for (int ks = 0; ks < 2; ++ks) { const bf16x8 pa = ldfrag<144>(lds + S_P, 16 * mt, 32 * ks, lane), x0 = ldfrag<144>(lds + S_XT, 16 * nt0, 32 * ks, lane), x1 = ldfrag<144>(lds + S_XT, 16 * (nt0 + 1), 32 * ks, lane);
            o0 = MFMA16(x0, pa, o0); o1 = MFMA16(x1, pa, o1); }
        { const int pc0 = 16 * nt0 + 4 * (lane >> 4);
          const u32x2 xs0 = *(const LAS u32x2*)(lds + S_XS + ii * 144 + pc0 * 2), xs1 = *(const LAS u32x2*)(lds + S_XS + ii * 144 + (pc0 + 16) * 2);
          f32x4 y0, y1;
          y0[0] = (o0[0] + dsk * bflo(xs0.x)) * siluf_(bflo(z0.x)); y0[1] = (o0[1] + dsk * bfhi(xs0.x)) * siluf_(bfhi(z0.x)); y0[2] = (o0[2] + dsk * bflo(xs0.y)) * siluf_(bflo(z0.y)); y0[3] = (o0[3] + dsk * bfhi(xs0.y)) * siluf_(bfhi(z0.y));
          y1[0] = (o1[0] + dsk * bflo(xs1.x)) * siluf_(bflo(z1.x)); y1[1] = (o1[1] + dsk * bfhi(xs1.x)) * siluf_(bfhi(z1.x)); y1[2] = (o1[2] + dsk * bflo(xs1.y)) * siluf_(bflo(z1.y)); y1[3] = (o1[3] + dsk * bfhi(xs1.y)) * siluf_(bfhi(z1.y));
          float ss = ((y0[0] * y0[0] + y0[1] * y0[1]) + (y0[2] * y0[2] + y0[3] * y0[3])) + ((y1[0] * y1[0] + y1[1] * y1[1]) + (y1[2] * y1[2] + y1[3] * y1[3]));
          ss += __shfl_xor(ss, 16); ss += __shfl_xor(ss, 32);
          bf16_t* op = yab + (row0 + ii) * 1536 + h * 64 + pc0;
          *(u32x2*)op = pack4(y0); *(u32x2*)(op + 16) = pack4(y1);
          if (lane < 16) ssqb[(row0 + ii) * 32 + h * 2 + (wave & 1)] = ss; }
        o0 = (f32x4){0.f, 0.f, 0.f, 0.f}; o1 = o0;
        __syncthreads();
      }
    }
#undef SSD_LOAD
}

__device__ __forceinline__ void skinny_loga(const bf16_t* hb, const bf16_t* wt, const float* ssq, const float* gwt, const float* gbs, bf16_t* loga, int gw, int ngw, int lane) {
    for (int task2 = gw; task2 < T / 8; task2 += ngw) {
        const int task = task2 >> 1, half = task2 & 1;
        const int r0 = task * 16; f32x4 acc = (f32x4){0.f, 0.f, 0.f, 0.f};
        const bf16_t* ap = hb + (size_t)(r0 + (lane & 15)) * 1024 + (lane >> 4) * 8; const bf16_t* bp = wt + (size_t)(lane & 15) * 1024 + (lane >> 4) * 8;
#pragma unroll 4
        for (int kk = 0; kk < 32; ++kk) { const bf16x8 a = *(const bf16x8*)(ap + kk * 32), b = *(const bf16x8*)(bp + kk * 32); acc = MFMA16(a, b, acc); }
#pragma unroll
        for (int j = 0; j < 4; ++j) acc[j] *= row_rstd(ssq, r0 + (lane >> 4) * 4 + j);
        {
            float z[8][8];
#pragma unroll
            for (int m = 0; m < 8; ++m) { const float bsv = gbs[lane + 64 * m];
#pragma unroll
                for (int rr = 0; rr < 8; ++rr) z[rr][m] = bsv; }
            for (int r = 0; r < 16; ++r) {
                float gv[8];
#pragma unroll
                for (int m = 0; m < 8; ++m) gv[m] = gwt[r * 512 + lane + 64 * m];
#pragma unroll
                for (int rr = 0; rr < 8; ++rr) { const float sv = __int_as_float(__builtin_amdgcn_readlane(__float_as_int(acc[rr & 3]), r + 16 * (2 * half + (rr >> 2))));
#pragma unroll
                    for (int m = 0; m < 8; ++m) z[rr][m] += sv * gv[m]; }
            }
#pragma unroll
            for (int rr = 0; rr < 8; ++rr)
#pragma unroll
                for (int m = 0; m < 8; ++m) { const float zz = z[rr][m], la = (fminf(zz, 0.f) - __logf(1.0f + __expf(-fabsf(zz)))) * 0.0625f;
                    loga[(size_t)(r0 + 8 * half + rr) * 512 + lane + 64 * m] = (bf16_t)f2bf(la); }
        }
    }
}

__global__ void __launch_bounds__(NTHREADS, 2) mega_fwd(Args args) {
    extern __shared__ __attribute__((aligned(16))) unsigned char lds_raw[];
    LAS unsigned char* lds = (LAS unsigned char*)lds_raw;
    volatile LAS unsigned* MISC = (volatile LAS unsigned*)(lds + MISC_OFF);
    const int tid = threadIdx.x, lane = tid & 63, wave = __builtin_amdgcn_readfirstlane(tid >> 6);
    const int G = gridDim.x, bx = blockIdx.x;
    const int vcu = (G % 8 == 0) ? (bx % 8) * (G / 8) + bx / 8 : bx;
    const int gw = vcu * NWAVES + wave, NGW = G * NWAVES;
    const int gtid = gw * 64 + lane, NGT = NGW * 64;
    unsigned char* ws = args.ws;
    for (int u = tid; u < (LDS_BYTES - LDSCTL_OFF) / 4; u += NTHREADS) ((LAS unsigned*)(lds + LDSCTL_OFF))[u] = 0u;
    __syncthreads();
    XcdBarrier bar; bar.bar = (unsigned*)(ws + WS_CTL) + CW_BAR; bar.x = 0; bar.st = nullptr;
    if (!MK_PER_PHASE) bar = xcd_barrier_post((unsigned*)(ws + WS_CTL) + CW_BAR, MISC + 8);
    const int lo = args.ph_lo, hi = args.ph_hi;
#define IN(k) (lo <= (k) && (k) < hi)
#define SEAM(k) do { if (IN(k) && IN((k) + 1)) xcd_barrier(bar); } while (0)

    float* hres = args.out;
    float* ssq = (float*)(ws + WS_SSQ);
    bf16_t* hb = (bf16_t*)(ws + WS_HB);

    if (IN(0)) {
        LAS float* scr = (LAS float*)(lds + wave * 16384);
        for (int it = bx; it < 256; it += G) s5_tables_part(args, ws, lds, it >> 3, it & 7, tid);
        { FIn0 f{args.in[4], args.in[1]}; transpose_all(f, (bf16_t*)(ws + WS_W0IN), 1024, 3072, scr, lane, gw, NGW); }
        { FDt0 f{args.in[4], args.in[1]}; transpose_all(f, (bf16_t*)(ws + WS_W0DT), 1024, 32, scr, lane, gw, NGW); }
        { FPlain f{args.in[13], 512}; transpose_all(f, (bf16_t*)(ws + WS_W0GLU), 512, 512, scr, lane, gw, NGW); }
        float* rot = (float*)(ws + WS_ROT);
        for (int idx = gtid; idx < 2048 * 64; idx += NGT) { const int l = idx >> 6, i = idx & 63; const float invf = powf(10000.0f, -(float)i / 64.0f), ang = (float)l * invf; float sn, cs; sincosf(ang, &sn, &cs);
            *(f32x2*)(rot + (size_t)idx * 2) = (f32x2){cs, sn}; }
        const float* x = args.in[0];
        for (int row = gw; row < T; row += NGW) {
            const f32x4* xr = (const f32x4*)(x + (size_t)row * 1024) + lane; float s = 0.f; f32x4 v[4];
#pragma unroll
            for (int j = 0; j < 4; ++j) { v[j] = xr[64 * j]; s += (v[j][0] * v[j][0] + v[j][1] * v[j][1]) + (v[j][2] * v[j][2] + v[j][3] * v[j][3]); }
            s = wave_sum(s);
            u32x2* o = (u32x2*)(hb + (size_t)row * 1024) + lane;
#pragma unroll
            for (int j = 0; j < 4; ++j) { u32x2 w; w.x = pk2(v[j][0], v[j][1]); w.y = pk2(v[j][2], v[j][3]); o[64 * j] = w; }
            if (lane < 16) ssq[(size_t)row * 16 + lane] = lane == 0 ? s : 0.f;
        }
    }
    SEAM(0);
    if (IN(1)) {
        s5_expand(ws, gtid, NGT);
        skinny16(hb, (const bf16_t*)(ws + WS_W0DT), ssq, (float*)(ws + WS_DT), gw, NGW, lane);
        OrdStd S; S.init(hb, ws + WS_W0IN, 1024, 1024, T, 3072, 1024, G, bx);
        const GDesc gd{1024, 1024, 128L * 1024 * 2, 128L * 1024 * 2};
        EpiIn0 E{ssq, (bf16_t*)(ws + WS_UPERM), (bf16_t*)(ws + WS_ZS), (bf16_t*)(ws + WS_XBC)};
        gemm_phase<EpiIn0, OrdStd, true>(lds, gd, S, E);
    }
    SEAM(1);
    if (IN(2)) {
        if (bx < 32) {
            OrdS5A S{(const char*)(ws + WS_UPERM), (const char*)(ws + WS_S5W1), bx};
            const GDesc gd{1152, 1024, 128L * 1152 * 2, 0};
            EpiS5A E{(bf16_t*)(ws + WS_UPERM), (const float*)(ws + WS_A64)};
            gemm_phase<EpiS5A, OrdS5A, false>(lds, gd, S, E);
        } else if (bx < 160) {
            const int w = bx - 32, item = ((((w & 7) * 4 + (w >> 5)) << 2) | ((w >> 3) & 3)), h = item & 15;
            ssd_item(lds, ws, args.in[15], args.in[16], args.in[17][h], -expf(args.in[18][h]), args.in[19][h], item, wave, lane);
        } else {
            LAS float* scr = (LAS float*)(lds + wave * 16384); const int gw2 = (bx - 160) * NWAVES + wave, ngw2 = (G - 160) * NWAVES;
            { FOut0 f{args.in[21], args.in[20]}; transpose_all(f, (bf16_t*)(ws + WS_W0OUT), 1536, 1024, scr, lane, gw2, ngw2); }
            { FGu f{args.in[28], args.in[29], args.in[2]}; transpose_all(f, (bf16_t*)(ws + WS_W0GU), 1024, 5632, scr, lane, gw2, ngw2); }
            { FPlain f{args.in[30], 1024}; transpose_all(f, (bf16_t*)(ws + WS_W0DN), FFH, 1024, scr, lane, gw2, ngw2); }
        }
    }
    SEAM(2);
    if (IN(3)) {
        if (bx < 128) {
            OrdS5C S{(const char*)(ws + WS_UPERM), (const char*)(ws + WS_S5BC), bx};
            const GDesc gd{1152, 1536, 128L * 1152 * 2, 128L * 1536 * 2};
            EpiS5C E{(bf16_t*)(ws + WS_ZG)};
            gemm_phase<EpiS5C, OrdS5C, false>(lds, gd, S, E);
        } else {
            bf16_t* yab = (bf16_t*)(ws + WS_YAB); const float* ssqb = (const float*)(ws + WS_SSQB);
            for (int row = (bx - 128) * NWAVES + wave; row < T; row += (G - 128) * NWAVES) {
                const f32x4* sp = (const f32x4*)(ssqb + (size_t)row * 32); float sacc = 0.f;
#pragma unroll
                for (int j = 0; j < 8; ++j) { const f32x4 v = sp[j]; sacc += (v[0] + v[1]) + (v[2] + v[3]); }
                const float rs = rsqrtf(sacc * (1.0f / 1024.0f) + EPS);
                u32x2* p = (u32x2*)(yab + (size_t)row * 1536) + lane;
#pragma unroll
                for (int j = 0; j < 4; ++j) { u32x2 w = p[64 * j]; w.x = pk2(bflo(w.x) * rs, bfhi(w.x) * rs); w.y = pk2(bflo(w.y) * rs, bfhi(w.y) * rs); p[64 * j] = w; }
            }
        }
    }
    SEAM(3);
    if (IN(4)) {
        if (bx < 128) {
            OrdStd S; S.init(ws + WS_ZG, ws + WS_W0GLU, 512, 512, T, 512, 512, 128, bx);
            const GDesc gd{512, 512, 128L * 512 * 2, 128L * 512 * 2};
            EpiGlu E{(const bf16_t*)(ws + WS_ZG), args.in[14], (bf16_t*)(ws + WS_YAB)};
            gemm_phase<EpiGlu, OrdStd, false>(lds, gd, S, E);
        } else {
            LAS float* scr = (LAS float*)(lds + wave * 16384); const int gw2 = (bx - 128) * NWAVES + wave, ngw2 = (G - 128) * NWAVES;
            { FIn1 f{args.in[22], args.in[1] + 1024}; transpose_all(f, (bf16_t*)(ws + WS_W1IN), 1024, 4096, scr, lane, gw2, ngw2); }
            { FAlr f{args.in[22], args.in[1] + 1024}; transpose_all(f, (bf16_t*)(ws + WS_W1ALR), 1024, 32, scr, lane, gw2, ngw2); }
            { FGate f{args.in[22], args.in[1] + 1024}; transpose_all(f, (bf16_t*)(ws + WS_W1GT), 1024, 2048, scr, lane, gw2, ngw2); }
            { FOut1 f{args.in[27], args.in[23], args.in[26]}; transpose_all(f, (bf16_t*)(ws + WS_W1OUT), 2048, 1024, scr, lane, gw2, ngw2); }
            { FGu f{args.in[28] + (size_t)1024 * FFH, args.in[29] + (size_t)1024 * FFH, args.in[2] + 1024}; transpose_all(f, (bf16_t*)(ws + WS_W1GU), 1024, 5632, scr, lane, gw2, ngw2); }
            { FPlain f{args.in[30] + (size_t)FFH * 1024, 1024}; transpose_all(f, (bf16_t*)(ws + WS_W1DN), FFH, 1024, scr, lane, gw2, ngw2); }
        }
    }
    SEAM(4);
    if (IN(5)) {
        OrdStd S; S.init(ws + WS_YAB, ws + WS_W0OUT, 1536, 1536, T, 1024, 1536, G, bx);
        const GDesc gd{1536, 1536, 128L * 1536 * 2, 128L * 1536 * 2};
        EpiRes<0> E{args.in[0], hres, hb, ssq};
        gemm_phase<EpiRes<0>, OrdStd, true>(lds, gd, S, E);
    }
    SEAM(5);
    if (IN(6)) {
        OrdStd S; S.init(hb, ws + WS_W0GU, 1024, 1024, T, 5632, 1024, G, bx);
        const GDesc gd{1024, 1024, 128L * 1024 * 2, 128L * 1024 * 2};
        EpiGu E{ssq, (bf16_t*)(ws + WS_HID0)};
        gemm_phase<EpiGu, OrdStd, true>(lds, gd, S, E);
    }
    SEAM(6);
    if (IN(7)) {
        OrdStd S; S.init(ws + WS_HID0, ws + WS_W0DN, FFH, FFH, T, 1024, FFH, G, bx);
        const GDesc gd{FFH, FFH, 128L * FFH * 2, 128L * FFH * 2};
        EpiRes<1> E{hres, hres, hb, ssq};
        gemm_phase<EpiRes<1>, OrdStd, true>(lds, gd, S, E);
    }
    SEAM(7);
    if (IN(8)) {
        skinny_loga(hb, (const bf16_t*)(ws + WS_W1ALR), ssq, args.in[24], args.in[25], (bf16_t*)(ws + WS_LOGA), gw, NGW, lane);
        OrdStd S; S.init(hb, ws + WS_W1IN, 1024, 1024, T, 4096, 1024, G, bx);
        const GDesc gd{1024, 1024, 128L * 1024 * 2, 128L * 1024 * 2};
        EpiIn1 E{ssq, (const float*)(ws + WS_ROT), (bf16_t*)(ws + WS_QKV)};
        gemm_phase<EpiIn1, OrdStd, true>(lds, gd, S, E);
    }
    SEAM(8);
    if (IN(9)) {
        for (int item = bx; item < 256; item += G) mix2_item<false>(lds, ws, item, wave, lane);
    }
    SEAM(9);
    if (IN(10)) {
        for (int item = bx; item < 256; item += G) mix2_item<true>(lds, ws, item, wave, lane);
    }
    SEAM(10);
    if (IN(11)) {
        OrdStd S; S.init(hb, ws + WS_W1GT, 1024, 1024, T, 2048, 1024, G, bx);
        const GDesc gd{1024, 1024, 128L * 1024 * 2, 128L * 1024 * 2};
        EpiGate E{ssq, (bf16_t*)(ws + WS_QKV)};
        gemm_phase<EpiGate, OrdStd, true>(lds, gd, S, E);
    }
    SEAM(11);
    if (IN(12)) {
        OrdStd S; S.init(ws + WS_QKV + 2048 * 2, ws + WS_W1OUT, 4096, 2048, T, 1024, 2048, G, bx);
        const GDesc gd{4096, 2048, 128L * 4096 * 2, 128L * 2048 * 2};
        EpiRes<1> E{hres, hres, hb, ssq};
        gemm_phase<EpiRes<1>, OrdStd, true>(lds, gd, S, E);
    }
    SEAM(12);
    if (IN(13)) {
        OrdStd S; S.init(hb, ws + WS_W1GU, 1024, 1024, T, 5632, 1024, G, bx);
        const GDesc gd{1024, 1024, 128L * 1024 * 2, 128L * 1024 * 2};
        EpiGu E{ssq, (bf16_t*)(ws + WS_HID1)};
        gemm_phase<EpiGu, OrdStd, true>(lds, gd, S, E);
    }
    SEAM(13);
    if (IN(14)) {
        OrdStd S; S.init(ws + WS_HID1, ws + WS_W1DN, FFH, FFH, T, 1024, FFH, G, bx);
        const GDesc gd{FFH, FFH, 128L * FFH * 2, 128L * FFH * 2};
        EpiRes<2> E{hres, hres, hb, ssq};
        gemm_phase<EpiRes<2>, OrdStd, true>(lds, gd, S, E);
    }
    SEAM(14);
    if (IN(15)) {
        const float* fg = args.in[3];
        for (int row = gw; row < T; row += NGW) {
            const float rs = row_rstd(ssq, row);
            f32x4* p = (f32x4*)(hres + (size_t)row * 1024) + lane; const f32x4* gp = (const f32x4*)fg + lane;
#pragma unroll
            for (int j = 0; j < 4; ++j) p[64 * j] = p[64 * j] * rs * gp[64 * j];
        }
    }
#undef IN
#undef SEAM
}

extern "C" void kernel_launch(void* const* d_in, const int* in_sizes, int n_in, void* d_out, int out_size, void* d_ws, size_t ws_size, hipStream_t stream) {
    static int grid = 0;
    if (grid == 0) {
        if (n_in != 31 || out_size != T * DM || ws_size < WS_END) { fprintf(stderr, "kernel_launch: unexpected problem (n_in %d, out %d, ws %zu)\n", n_in, out_size, ws_size); grid = -1; return; }
        int dev = 0, cus = 0, per_cu = 0;
        if (hipGetDevice(&dev) != hipSuccess || hipDeviceGetAttribute(&cus, hipDeviceAttributeMultiprocessorCount, dev) != hipSuccess) { grid = -1; return; }
        if (hipFuncSetAttribute((const void*)mega_fwd, hipFuncAttributeMaxDynamicSharedMemorySize, LDS_BYTES) != hipSuccess) { fprintf(stderr, "kernel_launch: hipFuncSetAttribute failed\n"); grid = -1; return; }
        if (hipOccupancyMaxActiveBlocksPerMultiprocessor(&per_cu, (const void*)mega_fwd, NTHREADS, LDS_BYTES) != hipSuccess || per_cu < 1) { fprintf(stderr, "kernel_launch: occupancy query says %d blocks per CU\n", per_cu); grid = -1; (void)hipGetLastError(); return; }
        grid = cus;
    }
    if (grid < 0) return;
    (void)hipMemsetAsync((char*)d_ws + WS_CTL, 0, CTL_ZERO_BYTES, stream);
    Args a{};
    for (int i = 0; i < 31; ++i) a.in[i] = (const float*)d_in[i];
    a.out = (float*)d_out; a.ws = (unsigned char*)d_ws;
#if MK_PER_PHASE
    for (int p = 0; p < NPH; ++p) { a.ph_lo = p; a.ph_hi = p + 1; hipLaunchKernelGGL(mega_fwd, dim3(grid), dim3(NTHREADS), LDS_BYTES, stream, a); }
#else
    a.ph_lo = 0; a.ph_hi = NPH;
    void* kargs[] = {&a};
    hipError_t e = hipLaunchCooperativeKernel((const void*)mega_fwd, dim3(grid), dim3(NTHREADS), kargs, LDS_BYTES, stream);
    if (e != hipSuccess) fprintf(stderr, "kernel_launch: cooperative launch failed: %s (grid %d)\n", hipGetErrorString(e), grid);
#endif
}
```
